# Optimizing an MI355X kernel written in HIP

```python
import math
import jax, jax.numpy as jnp
from jax import lax
import numpy as np

D_MODEL = 1024
BATCH = 8
SEQ = 2048
DEPTH = 4

D_FF = ((8 * D_MODEL // 3 + 255) // 256) * 256
MIX_WIDTH = D_MODEL
SGU_WIDTH = MIX_WIDTH // 2
SGU_GROUP_DIM = 64
SGU_GROUPS = SGU_WIDTH // SGU_GROUP_DIM
CHUNK = 128
DIFF_WIDTH = MIX_WIDTH - SGU_WIDTH
DIFF_V_DIM = 128
DIFF_QK_DIM = DIFF_V_DIM // 2
DIFF_HEADS = DIFF_WIDTH // DIFF_V_DIM
IN_COLS = 2 * SGU_WIDTH + 3 * DIFF_WIDTH
Q_BLOCK = 128
EPS = 1e-6
NEG_INF = -1e30

kernel_name = "hybrid_sgu_diffattn_macaron"


def rmsnorm(x, gain):
    x32 = x.astype(jnp.float32)
    y = x32 * lax.rsqrt(jnp.mean(x32 * x32, axis=-1, keepdims=True) + EPS)
    return (y * gain.astype(jnp.float32)).astype(x.dtype)


def swiglu(h, w_gate, w_up, w_down):
    return (jax.nn.silu(h @ w_gate) * (h @ w_up)) @ w_down


def alibi_slopes(n_heads):
    i = jnp.arange(1, n_heads + 1, dtype=jnp.float32)
    return jnp.exp2(-8.0 * i / n_heads)


def spatial_gating(z, norm_gain, w_s, b_s):
    b, s, _ = z.shape
    nc = s // CHUNK
    u = z[..., :SGU_WIDTH].reshape(b, nc, CHUNK, SGU_GROUPS, SGU_GROUP_DIM)
    v = z[..., SGU_WIDTH:].reshape(b, s, SGU_GROUPS, SGU_GROUP_DIM)
    v = rmsnorm(v, norm_gain).reshape(b, nc, CHUNK, SGU_GROUPS, SGU_GROUP_DIM)
    causal = jnp.tril(jnp.ones((CHUNK, CHUNK), dtype=bool))
    w = jnp.where(causal[None], w_s, jnp.zeros_like(w_s))
    gate = jnp.einsum('gts,bcsgd->bctgd', w, v) + jnp.transpose(b_s)[None, None, :, :, None]
    return (u * gate).reshape(b, s, SGU_WIDTH)


def diff_attention(q, k, v, lam, slopes):
    b, s, h, _ = q.shape
    nb = s // Q_BLOCK
    scale = DIFF_QK_DIM ** -0.5
    qh = jnp.transpose(q, (0, 2, 1, 3)) * scale
    kh = jnp.transpose(k, (0, 2, 1, 3))
    vh = jnp.transpose(v, (0, 2, 1, 3))
    k1, k2 = kh[..., :DIFF_QK_DIM], kh[..., DIFF_QK_DIM:]
    qb = qh.reshape(b, h, nb, Q_BLOCK, 2 * DIFF_QK_DIM).transpose(2, 0, 1, 3, 4)
    kpos = jnp.arange(s)

    def block(args):
        qblk, i = args
        qpos = i * Q_BLOCK + jnp.arange(Q_BLOCK)
        dist = qpos[:, None] - kpos[None, :]
        bias = -slopes[:, None, None] * dist.astype(jnp.float32)[None]
        causal = dist >= 0

        def probs(qq, kk):
            sc = jnp.einsum('bhqd,bhkd->bhqk', qq, kk).astype(jnp.float32) + bias
            sc = jnp.where(causal, sc, NEG_INF)
            return jax.nn.softmax(sc, axis=-1)

        p = probs(qblk[..., :DIFF_QK_DIM], k1) - lam * probs(qblk[..., DIFF_QK_DIM:], k2)
        return jnp.einsum('bhqk,bhkd->bhqd', p.astype(vh.dtype), vh)

    o = lax.map(block, (qb, jnp.arange(nb)))
    return o.transpose(1, 0, 3, 2, 4).reshape(b, s, h, DIFF_V_DIM)


def setup_inputs(seed: int = 0) -> dict:
    key = jax.random.key(seed)
    ks = jax.random.split(key, 24)
    f32 = jnp.float32

    def nrm(k, shape, scale):
        return jax.random.normal(k, shape, f32) * scale

    def gain(k, shape):
        return 1.0 + 0.02 * jax.random.normal(k, shape, f32)

    return {
        "x": jax.random.normal(ks[0], (BATCH, SEQ, D_MODEL), f32),
        "ffn1_norm": gain(ks[1], (DEPTH, D_MODEL)),
        "ffn1_w_gate": nrm(ks[2], (DEPTH, D_MODEL, D_FF), D_MODEL ** -0.5),
        "ffn1_w_up": nrm(ks[3], (DEPTH, D_MODEL, D_FF), D_MODEL ** -0.5),
        "ffn1_w_down": nrm(ks[4], (DEPTH, D_FF, D_MODEL), D_FF ** -0.5),
        "mix_norm": gain(ks[5], (DEPTH, D_MODEL)),
        "w_in": nrm(ks[6], (DEPTH, D_MODEL, IN_COLS), D_MODEL ** -0.5),
        "sgu_norm": gain(ks[7], (DEPTH, SGU_GROUPS, SGU_GROUP_DIM)),
        "sgu_w": nrm(ks[8], (DEPTH, SGU_GROUPS, CHUNK, CHUNK), 0.5 * CHUNK ** -0.5),
        "sgu_b": 1.0 + 0.01 * jax.random.normal(ks[9], (DEPTH, SGU_GROUPS, CHUNK), f32),
        "lambda_q1": nrm(ks[10], (DEPTH, DIFF_QK_DIM), 0.1),
        "lambda_k1": nrm(ks[11], (DEPTH, DIFF_QK_DIM), 0.1),
        "lambda_q2": nrm(ks[12], (DEPTH, DIFF_QK_DIM), 0.1),
        "lambda_k2": nrm(ks[13], (DEPTH, DIFF_QK_DIM), 0.1),
        "diff_subln": gain(ks[14], (DEPTH, DIFF_V_DIM)),
        "w_out": nrm(ks[15], (DEPTH, MIX_WIDTH, D_MODEL), MIX_WIDTH ** -0.5),
        "ffn2_norm": gain(ks[16], (DEPTH, D_MODEL)),
        "ffn2_w_gate": nrm(ks[17], (DEPTH, D_MODEL, D_FF), D_MODEL ** -0.5),
        "ffn2_w_up": nrm(ks[18], (DEPTH, D_MODEL, D_FF), D_MODEL ** -0.5),
        "ffn2_w_down": nrm(ks[19], (DEPTH, D_FF, D_MODEL), D_FF ** -0.5),
        "final_norm": gain(ks[20], (D_MODEL,)),
    }


def reference(x, ffn1_norm, ffn1_w_gate, ffn1_w_up, ffn1_w_down, mix_norm, w_in,
              sgu_norm, sgu_w, sgu_b, lambda_q1, lambda_k1, lambda_q2, lambda_k2,
              diff_subln, w_out, ffn2_norm, ffn2_w_gate, ffn2_w_up, ffn2_w_down,
              final_norm):
    b, s, _ = x.shape
    slopes = alibi_slopes(DIFF_HEADS)
    for l in range(DEPTH):
        x = x + 0.5 * swiglu(rmsnorm(x, ffn1_norm[l]), ffn1_w_gate[l], ffn1_w_up[l], ffn1_w_down[l])

        h = rmsnorm(x, mix_norm[l])
        proj = h @ w_in[l]
        z_a = jax.nn.gelu(proj[..., :2 * SGU_WIDTH], approximate=False)
        y_a = spatial_gating(z_a, sgu_norm[l], sgu_w[l], sgu_b[l])

        off = 2 * SGU_WIDTH
        q = proj[..., off:off + DIFF_WIDTH].reshape(b, s, DIFF_HEADS, DIFF_V_DIM)
        k = proj[..., off + DIFF_WIDTH:off + 2 * DIFF_WIDTH].reshape(b, s, DIFF_HEADS, DIFF_V_DIM)
        v = proj[..., off + 2 * DIFF_WIDTH:off + 3 * DIFF_WIDTH].reshape(b, s, DIFF_HEADS, DIFF_V_DIM)
        lam_init = 0.8 - 0.6 * math.exp(-0.3 * l)
        lam = (jnp.exp(jnp.sum(lambda_q1[l].astype(jnp.float32) * lambda_k1[l].astype(jnp.float32)))
               - jnp.exp(jnp.sum(lambda_q2[l].astype(jnp.float32) * lambda_k2[l].astype(jnp.float32)))
               + lam_init)
        o = diff_attention(q, k, v, lam, slopes)
        o = rmsnorm(o, diff_subln[l]) * (1.0 - lam_init)
        y_b = o.reshape(b, s, DIFF_WIDTH)

        x = x + jnp.concatenate([y_a, y_b], axis=-1) @ w_out[l]

        x = x + 0.5 * swiglu(rmsnorm(x, ffn2_norm[l]), ffn2_w_gate[l], ffn2_w_up[l], ffn2_w_down[l])
    return rmsnorm(x, final_norm)
```

```cpp
#include <hip/hip_runtime.h>
#include <hip/hip_cooperative_groups.h>
#include <cstdio>
#include <cstdint>
namespace cg = cooperative_groups;
namespace pg8 {
#define PG8_LAS __attribute__((address_space(3)))
typedef unsigned short bf16_t;
typedef short bf16x8 __attribute__((ext_vector_type(8)));
typedef float f32x4 __attribute__((ext_vector_type(4)));
typedef unsigned u32x4 __attribute__((ext_vector_type(4)));
constexpr int BM = 256, BK = 64, HALF = 128, HTB = HALF * BK * 2  , STAGE_BYTES = 8 * HTB, NXCD = 8, WGM = 8;

__host__ __device__ __forceinline__ int lds_byte(int r, int c) { const int st = (r >> 4) * 2 + (c >> 5), rr = r & 15, cc = c & 31, ob = rr * 64 + cc * 2; return st * 1024 + (ob ^ (((ob >> 9) & 1) << 5)); }
__host__ __device__ __forceinline__ void stage_rc(int b, int& R, int& C) { const int st = b / 1024, sb = b % 1024, swz = sb ^ (((sb >> 9) & 1) << 5); R = (st >> 1) * 16 + swz / 64; C = (st & 1) * 32 + (swz % 64) / 2; }
__host__ __device__ __forceinline__ int perm32(int rho) { const int n = rho >> 4, i = rho & 15; return 8 * (i >> 2) + 4 * n + (i & 3); }

struct Unit { int pm, pn; };
struct Gemm { const bf16_t* A; const bf16_t* Bt; int M, N, K; };

struct StaticOrder {
    int nM, nN, nwg, G, c;
    __host__ __device__ void init(int M, int N, int G_, int c_) { nM = M / BM; nN = N / BM; nwg = nM * nN; G = G_; c = c_; }
    __host__ __device__ bool next(int i, Unit& u) const {
        const long L = (long)i * G + c; if (L >= nwg) return false;
        int wgid = (int)L; { const int q = nwg / NXCD, r = nwg % NXCD, xcd = wgid % NXCD, off = wgid / NXCD; wgid = (xcd < r ? xcd * (q + 1) : r * (q + 1) + (xcd - r) * q) + off; }
        const int nig = WGM * nN, gid = wgid / nig, fm = gid * WGM, gsz = (nM - fm) < WGM ? (nM - fm) : WGM;
        u.pm = fm + ((wgid % nig) % gsz); u.pn = (wgid % nig) / gsz; return true;
    }
    __device__ __forceinline__ void a_ready(const Unit&) const {}
    __device__ __forceinline__ void done(const Unit&) const {}
};

typedef float f32x2c_t __attribute__((ext_vector_type(2))); typedef __bf16 bf16x2c_t __attribute__((ext_vector_type(2)));
__device__ __forceinline__ unsigned cvt_pk_bf16(float lo, float hi) { f32x2c_t v = {lo, hi}; bf16x2c_t b = __builtin_convertvector(v, bf16x2c_t); return __builtin_bit_cast(unsigned, b); }
typedef float f32x2 __attribute__((ext_vector_type(2)));
__device__ __forceinline__ f32x2 gelu_pk(f32x2 v) {
    const f32x2 av = __builtin_elementwise_abs(v), d = av * 0.2316418882f + 1.0f;
    f32x2 t; t.x = __builtin_amdgcn_rcpf(d.x); t.y = __builtin_amdgcn_rcpf(d.y);
    f32x2 q = t * 0.5307027145f + (-0.7265760135f); q = q * t + 0.7107068705f; q = q * t + (-0.142248368f); q = q * t + 0.127414796f; q = q * t;
    const f32x2 s = (v * v) * (-0.72134752044f);
    f32x2 e; e.x = __builtin_amdgcn_exp2f(s.x); e.y = __builtin_amdgcn_exp2f(s.y);
    const f32x2 m = v * (q * e), r = v - m;
    f32x2 o; o.x = v.x < 0.f ? m.x : r.x; o.y = v.y < 0.f ? m.y : r.y; return o;
}

__device__ __forceinline__ unsigned short f2bf1(float f) { unsigned u = __builtin_bit_cast(unsigned, f); return (unsigned short)((u + 0x7fffu + ((u >> 16) & 1u)) >> 16); }
constexpr float RMS_EPS = 1e-6f;
__device__ __forceinline__ float xsum16(float v) { const auto r = __builtin_amdgcn_permlane16_swap(__builtin_bit_cast(unsigned, v), __builtin_bit_cast(unsigned, v), false, false); return __builtin_bit_cast(float, (unsigned)r[0]) + __builtin_bit_cast(float, (unsigned)r[1]); }
__device__ __forceinline__ float xsum32(float v) { const auto r = __builtin_amdgcn_permlane32_swap(__builtin_bit_cast(unsigned, v), __builtin_bit_cast(unsigned, v), false, false); return __builtin_bit_cast(float, (unsigned)r[0]) + __builtin_bit_cast(float, (unsigned)r[1]); }
__device__ __forceinline__ void row_rstd8(const float* rowss, int row0, int fq, float (&rsv)[2][4]) {
    f32x4 pv[2][4];
#pragma unroll
    for (int ai = 0; ai < 2; ++ai)
#pragma unroll
        for (int m = 0; m < 4; ++m) pv[ai][m] = *(const f32x4*)(rowss + (size_t)(row0 + ai * HALF + m * 16) * 16 + 4 * fq);
#pragma unroll
    for (int ai = 0; ai < 2; ++ai)
#pragma unroll
        for (int m = 0; m < 4; ++m) rsv[ai][m] = (pv[ai][m][0] + pv[ai][m][1]) + (pv[ai][m][2] + pv[ai][m][3]);
#pragma unroll
    for (int ai = 0; ai < 2; ++ai)
#pragma unroll
        for (int m = 0; m < 4; ++m) rsv[ai][m] = xsum16(rsv[ai][m]);
#pragma unroll
    for (int ai = 0; ai < 2; ++ai)
#pragma unroll
        for (int m = 0; m < 4; ++m) rsv[ai][m] = xsum32(rsv[ai][m]);
#pragma unroll
    for (int ai = 0; ai < 2; ++ai)
#pragma unroll
        for (int m = 0; m < 4; ++m) rsv[ai][m] = __builtin_amdgcn_rsqf(rsv[ai][m] * (1.0f / 1024.0f) + RMS_EPS);
}
__device__ __forceinline__ float row_rstd(const float* rowss, int row, int fq) {
    const f32x4 pv = *(const f32x4*)(rowss + (size_t)row * 16 + 4 * fq);
    float s = (pv[0] + pv[1]) + (pv[2] + pv[3]);
    s += __shfl_xor(s, 16); s += __shfl_xor(s, 32);
    return __builtin_amdgcn_rsqf(s * (1.0f / 1024.0f) + RMS_EPS);
}
struct EpiSwiglu {
    static constexpr bool PERM = true, AFTER_DRAIN = false;
    bf16_t* O; int ldo; const float* rowss;
    __device__ __forceinline__ void operator()(const f32x4 (&acc)[2][2][4][2], const Unit& u, int wr, int wc, int fr, int fq) const {
        const int row0 = u.pm * BM + wr * 64 + fr, col0 = u.pn * HALF + wc * 32 + 8 * fq;
        float rsv[2][4]; row_rstd8(rowss, row0, fq, rsv);
#pragma unroll
        for (int ai = 0; ai < 2; ++ai)
#pragma unroll
            for (int m = 0; m < 4; ++m) {
                const int row = row0 + ai * HALF + m * 16;
                const float rs = rsv[ai][m];
                float o[8]; const float rs2 = rs * rs, nrs = rs * -1.4426950408889634f;
#pragma unroll
                for (int n = 0; n < 2; ++n) {
                    const f32x4 t = (acc[ai][0][m][n] * acc[ai][1][m][n]) * rs2, ea = acc[ai][0][m][n] * nrs;
#pragma unroll
                    for (int e = 0; e < 4; ++e) o[n * 4 + e] = t[e] * __builtin_amdgcn_rcpf(1.0f + __builtin_amdgcn_exp2f(ea[e]));
                }
                u32x4 w; w.x = cvt_pk_bf16(o[0], o[1]); w.y = cvt_pk_bf16(o[2], o[3]); w.z = cvt_pk_bf16(o[4], o[5]); w.w = cvt_pk_bf16(o[6], o[7]);
                *(u32x4*)(O + (size_t)row * ldo + col0) = w;
            }
    }
};
struct EpiResid {
    static constexpr bool PERM = true, AFTER_DRAIN = false;
    const float* Xin; float* X; bf16_t* XB; float* rowss_next; float scale;
    __device__ __forceinline__ void operator()(const f32x4 (&acc)[2][2][4][2], const Unit& u, int wr, int wc, int fr, int fq) const {
        const int row0 = u.pm * BM + wr * 64 + fr, col0 = u.pn * BM + wc * 32 + 8 * fq;
#pragma unroll
        for (int ai = 0; ai < 2; ++ai)
#pragma unroll
          for (int mh = 0; mh < 2; ++mh) {
            f32x4 xv[2][2][2];
#pragma unroll
            for (int mm = 0; mm < 2; ++mm)
#pragma unroll
                for (int bj = 0; bj < 2; ++bj) {
                    const float* xi = Xin + (size_t)(row0 + ai * HALF + (2 * mh + mm) * 16) * 1024 + col0 + bj * HALF;
                    xv[mm][bj][0] = *(const f32x4*)xi; xv[mm][bj][1] = *(const f32x4*)(xi + 4);
                }
#pragma unroll
            for (int mm = 0; mm < 2; ++mm) {
                const int m = 2 * mh + mm;
                const int row = row0 + ai * HALF + m * 16;
                float ss = 0.f;
#pragma unroll
                for (int bj = 0; bj < 2; ++bj) {
                    float* xp = X + (size_t)row * 1024 + col0 + bj * HALF;
                    const f32x4 x0 = xv[mm][bj][0] + acc[ai][bj][m][0] * scale, x1 = xv[mm][bj][1] + acc[ai][bj][m][1] * scale;
                    *(f32x4*)xp = x0; *(f32x4*)(xp + 4) = x1;
                    ss += (x0[0] * x0[0] + x0[1] * x0[1]) + (x0[2] * x0[2] + x0[3] * x0[3]) + (x1[0] * x1[0] + x1[1] * x1[1]) + (x1[2] * x1[2] + x1[3] * x1[3]);
                    u32x4 w; w.x = cvt_pk_bf16(x0[0], x0[1]); w.y = cvt_pk_bf16(x0[2], x0[3]); w.z = cvt_pk_bf16(x1[0], x1[1]); w.w = cvt_pk_bf16(x1[2], x1[3]);
                    *(u32x4*)(XB + (size_t)row * 1024 + col0 + bj * HALF) = w;
                }
                ss = xsum32(xsum16(ss));
                if (fq == 0) rowss_next[(size_t)row * 16 + u.pn * 4 + wc] = ss;
            }
          }
    }
};
struct EpiWin {
    static constexpr bool PERM = true, AFTER_DRAIN = false;
    bf16_t *Z, *Q, *Kb, *Vt; const float* rowss; float qscale;
    __device__ __forceinline__ void operator()(const f32x4 (&acc)[2][2][4][2], const Unit& u, int wr, int wc, int fr, int fq) const {
        const int row0 = u.pm * BM + wr * 64 + fr, cw = wc * 32 + 8 * fq;
        float rsv[2][4]; row_rstd8(rowss, row0, fq, rsv);
#pragma unroll
        for (int ai = 0; ai < 2; ++ai)
#pragma unroll
            for (int m = 0; m < 4; ++m) {
                const int row = row0 + ai * HALF + m * 16;
                const float rs = rsv[ai][m];
                if (u.pn < 4) {
#pragma unroll
                    for (int bj = 0; bj < 2; ++bj) {
                        const f32x4 v0 = acc[ai][bj][m][0] * rs, v1 = acc[ai][bj][m][1] * rs;
                        const f32x2 a = gelu_pk((f32x2){v0[0], v0[1]}), b = gelu_pk((f32x2){v0[2], v0[3]}), c = gelu_pk((f32x2){v1[0], v1[1]}), d = gelu_pk((f32x2){v1[2], v1[3]});
                        u32x4 w; w.x = cvt_pk_bf16(a.x, a.y); w.y = cvt_pk_bf16(b.x, b.y); w.z = cvt_pk_bf16(c.x, c.y); w.w = cvt_pk_bf16(d.x, d.y);
                        *(u32x4*)(Z + (size_t)row * 1024 + u.pn * BM + bj * HALF + cw) = w;
                    }
                } else if (u.pn < 8) {
                    bf16_t* base = (u.pn < 6) ? Q : Kb; const float sc = (u.pn < 6) ? rs * qscale : rs; const int ct = (u.pn & 1) * BM;
#pragma unroll
                    for (int bj = 0; bj < 2; ++bj) {
                        const f32x4 v0 = acc[ai][bj][m][0] * sc, v1 = acc[ai][bj][m][1] * sc;
                        u32x4 w; w.x = cvt_pk_bf16(v0[0], v0[1]); w.y = cvt_pk_bf16(v0[2], v0[3]); w.z = cvt_pk_bf16(v1[0], v1[1]); w.w = cvt_pk_bf16(v1[2], v1[3]);
                        *(u32x4*)(base + (size_t)row * 512 + ct + bj * HALF + cw) = w;
                    }
                } else {
                    const int b = row >> 11, s = row & 2047;
#pragma unroll
                    for (int bj = 0; bj < 2; ++bj) {
                        const int h = 2 * (u.pn - 8) + bj;
                        bf16_t* vp = Vt + ((size_t)(b * 4 + h) * 128 + cw) * 2048 + s;
#pragma unroll
                        for (int n = 0; n < 2; ++n)
#pragma unroll
                            for (int e = 0; e < 4; ++e) vp[(size_t)(n * 4 + e) * 2048] = f2bf1(acc[ai][bj][m][n][e] * rs);
                    }
                }
            }
    }
};
template <class Epi, class Sched, bool ALIGN_EPI = false, bool SP2 = false>
__device__ __forceinline__ void gemm_phase(PG8_LAS unsigned char* lds, const Gemm g, const Sched& S, const Epi& E) {
    int tid_ = threadIdx.x; asm volatile("" : "+v"(tid_));
    const int tid = tid_, wid = __builtin_amdgcn_readfirstlane(tid >> 6), lane = tid & 63, wr = wid >> 2, wc = wid & 3, fr = lane & 15, fq = lane >> 4;
    const int K = g.K, nt = K / BK;
    unsigned voffA[2], voffB[2];
#pragma unroll
    for (int i = 0; i < 2; ++i) { int R, C; stage_rc(tid * 16 + i * 8192, R, C); const int Rb = Epi::PERM ? ((R & ~31) + perm32(R & 31)) : R;
        voffA[i] = (unsigned)(R * K + C) * 2u; voffB[i] = (unsigned)(Rb * K + C) * 2u; }
    const size_t kstep = (size_t)(BK * 2);
    const size_t hstep = (size_t)HALF * K * 2;
    const size_t tstep = 2 * hstep;
    const unsigned ldsw = (unsigned)wid * 1024u;
    const int aoff = lds_byte(wr * 64 + fr, fq * 8), boff = lds_byte(wc * 32 + fr, fq * 8);
#define PG8_SA(b, h) (((b) * 2 + (h)) * HTB)
#define PG8_SB(b, h) ((4 + (b) * 2 + (h)) * HTB)
#define PG8_STAGE(bufoff, gbase, voff) do { _Pragma("unroll") for (int _i = 0; _i < 2; ++_i) \
        __builtin_amdgcn_global_load_lds((const unsigned*)((const char*)(gbase) + (voff)[_i]), (PG8_LAS unsigned*)(lds + (bufoff) + ldsw + _i * 8192), 16, 0, 0); } while (0)
#define PG8_LDA(dst, b, h) do { _Pragma("unroll") for (int m = 0; m < 4; ++m) _Pragma("unroll") for (int k = 0; k < 2; ++k) dst[m][k] = *(const PG8_LAS bf16x8*)(lds + PG8_SA(b, h) + aoff + m * 2048 + k * 1024); } while (0)
#define PG8_LDB(dst, b, h) do { _Pragma("unroll") for (int n = 0; n < 2; ++n) _Pragma("unroll") for (int k = 0; k < 2; ++k) dst[n][k] = *(const PG8_LAS bf16x8*)(lds + PG8_SB(b, h) + boff + n * 2048 + k * 1024); } while (0)
#define PG8_MMA(ai, bj, At, Bt) do { __builtin_amdgcn_s_setprio(1); _Pragma("unroll") for (int m = 0; m < 4; ++m) _Pragma("unroll") for (int n = 0; n < 2; ++n) _Pragma("unroll") for (int k = 0; k < 2; ++k) \
        acc[ai][bj][m][n] = __builtin_amdgcn_mfma_f32_16x16x32_bf16(Bt[n][k], At[m][k], acc[ai][bj][m][n], 0, 0, 0); __builtin_amdgcn_s_setprio(0); } while (0)
#define PG8_WAIT_V(n) asm volatile("s_waitcnt vmcnt(" #n ")" ::: "memory")
#define PG8_WAIT_L(n) asm volatile("s_waitcnt lgkmcnt(" #n ")" ::: "memory")
#define PG8_BAR __builtin_amdgcn_s_barrier()
#define PG8_SCHED __builtin_amdgcn_sched_barrier(0)
    Unit cur, nxt; int ui = 0;
    if (!S.next(0, cur)) return;
    f32x4 acc[2][2][4][2];
#pragma unroll
    for (int a = 0; a < 2; ++a)
#pragma unroll
        for (int b = 0; b < 2; ++b)
#pragma unroll
            for (int m = 0; m < 4; ++m)
#pragma unroll
                for (int n = 0; n < 2; ++n) acc[a][b][m][n] = (f32x4){0.f, 0.f, 0.f, 0.f};
    bf16x8 At[4][2], B0[2][2], B1[2][2];
    const char* cA = (const char*)g.A + (size_t)cur.pm * tstep; const char* cB = (const char*)g.Bt + (size_t)cur.pn * tstep;
    S.a_ready(cur);
    if constexpr (SP2) {
        PG8_STAGE(PG8_SB(0, 0), cB, voffB); PG8_STAGE(PG8_SB(0, 1), cB + hstep, voffB); PG8_STAGE(PG8_SA(0, 0), cA, voffA); PG8_STAGE(PG8_SA(0, 1), cA + hstep, voffA);
        if (wr == 1) PG8_BAR;
        PG8_WAIT_V(2); PG8_BAR;
        PG8_STAGE(PG8_SB(1, 0), cB + kstep, voffB); PG8_STAGE(PG8_SA(1, 0), cA + kstep, voffA); PG8_STAGE(PG8_SB(1, 1), cB + hstep + kstep, voffB);
        PG8_WAIT_V(6); PG8_BAR;
    } else {
        PG8_STAGE(PG8_SB(0, 0), cB, voffB); PG8_STAGE(PG8_SA(0, 0), cA, voffA); PG8_STAGE(PG8_SB(0, 1), cB + hstep, voffB); PG8_STAGE(PG8_SA(0, 1), cA + hstep, voffA);
        if (wr == 1) PG8_BAR;
        PG8_WAIT_V(4); PG8_BAR;
        PG8_STAGE(PG8_SB(1, 0), cB + kstep, voffB); PG8_STAGE(PG8_SA(1, 0), cA + kstep, voffA); PG8_STAGE(PG8_SB(1, 1), cB + hstep + kstep, voffB);
        PG8_WAIT_V(6); PG8_BAR;
    }
    for (;;) {
        const bool has_next = S.next(ui + 1, nxt);
        const char* nA = has_next ? (const char*)g.A + (size_t)nxt.pm * tstep : cA; const char* nB = has_next ? (const char*)g.Bt + (size_t)nxt.pn * tstep : cB;
        for (int t = 0; t < nt; t += 2) {
            const bool last = (t == nt - 2);
            const char* a1 = cA + (size_t)(t + 1) * kstep;
            const char* a2 = last ? nA : cA + (size_t)(t + 2) * kstep; const char* b2 = last ? nB : cB + (size_t)(t + 2) * kstep;
            const char* a3 = a2 + kstep; const char* b3 = b2 + kstep;
            if (last && has_next) S.a_ready(nxt);
            if constexpr (SP2) {
            PG8_LDB(B0, 0, 0); PG8_LDB(B1, 0, 1); PG8_SCHED; PG8_LDA(At, 0, 0); PG8_STAGE(PG8_SA(1, 1), a1 + hstep, voffA);
            PG8_WAIT_V(8); PG8_WAIT_L(0); PG8_BAR; PG8_MMA(0, 0, At, B0); PG8_MMA(0, 1, At, B1); PG8_BAR; PG8_SCHED;
            PG8_LDA(At, 0, 1); PG8_STAGE(PG8_SB(0, 0), b2, voffB); PG8_STAGE(PG8_SB(0, 1), b2 + hstep, voffB); PG8_STAGE(PG8_SA(0, 0), a2, voffA);
            PG8_WAIT_V(8); PG8_WAIT_L(0); PG8_BAR; PG8_MMA(1, 0, At, B0); PG8_MMA(1, 1, At, B1); PG8_BAR; PG8_SCHED;
            PG8_LDB(B0, 1, 0); PG8_LDB(B1, 1, 1); PG8_SCHED; PG8_LDA(At, 1, 0); PG8_STAGE(PG8_SA(0, 1), a2 + hstep, voffA);
            PG8_WAIT_V(8); PG8_WAIT_L(0); PG8_BAR; PG8_MMA(0, 0, At, B0); PG8_MMA(0, 1, At, B1); PG8_BAR; PG8_SCHED;
            PG8_LDA(At, 1, 1); PG8_STAGE(PG8_SB(1, 0), b3, voffB); PG8_STAGE(PG8_SB(1, 1), b3 + hstep, voffB); PG8_STAGE(PG8_SA(1, 0), a3, voffA);
            PG8_WAIT_V(8); PG8_WAIT_L(0); PG8_BAR; PG8_MMA(1, 0, At, B0); PG8_MMA(1, 1, At, B1); PG8_BAR; PG8_SCHED;
            } else {
            PG8_LDB(B0, 0, 0); PG8_SCHED; PG8_LDA(At, 0, 0); PG8_STAGE(PG8_SA(1, 1), a1 + hstep, voffA);
            PG8_WAIT_L(8); PG8_BAR; PG8_WAIT_L(0); PG8_MMA(0, 0, At, B0); PG8_BAR; PG8_SCHED;
            PG8_LDB(B1, 0, 1); PG8_STAGE(PG8_SB(0, 0), b2, voffB);
            PG8_BAR; PG8_WAIT_L(0); PG8_MMA(0, 1, At, B1); PG8_BAR;
            PG8_LDA(At, 0, 1); PG8_STAGE(PG8_SA(0, 0), a2, voffA);
            PG8_BAR; PG8_WAIT_L(0); PG8_MMA(1, 0, At, B0); PG8_BAR; PG8_SCHED;
            PG8_STAGE(PG8_SB(0, 1), b2 + hstep, voffB);
            PG8_WAIT_V(6); PG8_BAR; PG8_MMA(1, 1, At, B1); PG8_BAR;
            PG8_LDB(B0, 1, 0); PG8_SCHED; PG8_LDA(At, 1, 0); PG8_STAGE(PG8_SA(0, 1), a2 + hstep, voffA);
            PG8_WAIT_L(8); PG8_BAR; PG8_WAIT_L(0); PG8_MMA(0, 0, At, B0); PG8_BAR; PG8_SCHED;
            PG8_LDB(B1, 1, 1); PG8_STAGE(PG8_SB(1, 0), b3, voffB);
            PG8_BAR; PG8_WAIT_L(0); PG8_MMA(0, 1, At, B1); PG8_BAR;
            PG8_LDA(At, 1, 1); PG8_STAGE(PG8_SA(1, 0), a3, voffA);
            PG8_BAR; PG8_WAIT_L(0); PG8_MMA(1, 0, At, B0); PG8_BAR; PG8_SCHED;
            PG8_STAGE(PG8_SB(1, 1), b3 + hstep, voffB);
            PG8_WAIT_V(6); PG8_BAR; PG8_MMA(1, 1, At, B1); PG8_BAR;
            }
        }
        if constexpr (ALIGN_EPI) { if (wr == 0) PG8_BAR; }
        if constexpr (!Epi::AFTER_DRAIN) { E(acc, cur, wr, wc, fr, fq); S.done(cur); }
        if (!has_next) break;
#pragma unroll
        for (int a = 0; a < 2; ++a)
#pragma unroll
            for (int b = 0; b < 2; ++b)
#pragma unroll
                for (int m = 0; m < 4; ++m)
#pragma unroll
                    for (int n = 0; n < 2; ++n) acc[a][b][m][n] = (f32x4){0.f, 0.f, 0.f, 0.f};
        cur = nxt; cA = nA; cB = nB; ++ui;
        if constexpr (ALIGN_EPI) { if (wr == 1) PG8_BAR; }
    }
    PG8_WAIT_V(0);
    if constexpr (!ALIGN_EPI) { if (wr == 0) PG8_BAR; }
    PG8_BAR;
    if constexpr (Epi::AFTER_DRAIN) { E.fused(acc, cur, wr, wc, fr, fq, lds, wid, lane); S.done(cur); }
#undef PG8_SA
#undef PG8_SB
#undef PG8_STAGE
#undef PG8_LDA
#undef PG8_LDB
#undef PG8_MMA
#undef PG8_WAIT_V
#undef PG8_WAIT_L
#undef PG8_BAR
#undef PG8_SCHED
}
}

#ifndef PROBE_MIX_REPS
#define PROBE_MIX_REPS 1
#endif
#ifndef PROBE_G1_REPS
#define PROBE_G1_REPS 1
#endif
#ifndef PROBE_G3_REPS
#define PROBE_G3_REPS 1
#endif
#ifndef PROBE_PRO_REPS
#define PROBE_PRO_REPS 1
#endif
#ifndef PROBE_BAR_REPS
#define PROBE_BAR_REPS 1
#endif
#ifndef PROBE_SGU_REPS
#define PROBE_SGU_REPS 1
#endif
#ifndef PROBE_ATT_REPS
#define PROBE_ATT_REPS 1
#endif
#define LAS __attribute__((address_space(3)))
using pg8::bf16_t; using pg8::bf16x8; using pg8::f32x4; using pg8::u32x4;
typedef float f32x16 __attribute__((ext_vector_type(16)));
typedef unsigned u32x2 __attribute__((ext_vector_type(2)));
constexpr int DM = 1024, NB = 8, SEQ = 2048, DEPTH = 4, M = NB * SEQ, DFF = 2816, NIN = 2560;
constexpr int NWAVES = 8, NTHREADS = 512;
constexpr int LDS_BYTES = 147456;
constexpr size_t SZ_WGU = (size_t)2 * DFF * DM * 2, SZ_WD = (size_t)DM * DFF * 2, SZ_WIN = (size_t)NIN * DM * 2, SZ_WOUT = (size_t)DM * DM * 2, SZ_SGUW = (size_t)8 * 128 * 128 * 2;
constexpr size_t LO_WGU1 = 0, LO_WD1 = LO_WGU1 + SZ_WGU, LO_WIN = LO_WD1 + SZ_WD, LO_WOUT = LO_WIN + SZ_WIN, LO_WGU2 = LO_WOUT + SZ_WOUT, LO_WD2 = LO_WGU2 + SZ_WGU, LO_SGUW = LO_WD2 + SZ_WD, L_STRIDE = LO_SGUW + SZ_SGUW;
constexpr size_t WS_W = 0, WS_X = WS_W + DEPTH * L_STRIDE, WS_XB = WS_X + (size_t)M * DM * 4, WS_RS = WS_XB + (size_t)M * DM * 2, WS_OV = WS_RS + (size_t)2 * M * 16 * 4;
constexpr size_t WS_ACT = WS_OV;
constexpr size_t WS_Z = WS_OV, WS_Q = WS_Z + (size_t)M * 1024 * 2, WS_K = WS_Q + (size_t)M * 512 * 2, WS_VT = WS_K + (size_t)M * 512 * 2, WS_Y = WS_VT + (size_t)M * 512 * 2;
constexpr size_t WS_CTL = WS_Y + (size_t)M * 1024 * 2, CTL_BYTES = 65536;
constexpr size_t WS_END = WS_CTL + CTL_BYTES;
static_assert(WS_ACT + (size_t)M * DFF * 2 <= WS_CTL, "overlay");
static_assert(L_STRIDE % 256 == 0 && WS_X % 256 == 0 && WS_OV % 256 == 0, "alignment");

__device__ __forceinline__ unsigned f2bf(float f) { unsigned u = __builtin_bit_cast(unsigned, f); return (u + 0x7fffu + ((u >> 16) & 1u)) >> 16; }
__device__ __forceinline__ unsigned pk2(float lo, float hi) { return f2bf(lo) | (f2bf(hi) << 16); }
typedef float f32x2_t __attribute__((ext_vector_type(2))); typedef __bf16 bf16x2_t __attribute__((ext_vector_type(2)));
__device__ __forceinline__ unsigned cvtpk(float lo, float hi) { f32x2_t v = {lo, hi}; bf16x2_t b = __builtin_convertvector(v, bf16x2_t); return __builtin_bit_cast(unsigned, b); }
__device__ __forceinline__ float bflo(unsigned w) { return __builtin_bit_cast(float, w << 16); }
__device__ __forceinline__ float bfhi(unsigned w) { return __builtin_bit_cast(float, w & 0xffff0000u); }
__device__ __forceinline__ float wave_sum(float v) {
#pragma unroll
    for (int o = 1; o < 64; o <<= 1) v += __shfl_xor(v, o);
    return v;
}
#define WG_BAR() do { asm volatile("s_waitcnt vmcnt(0) lgkmcnt(0)" ::: "memory"); __builtin_amdgcn_s_barrier(); asm volatile("" ::: "memory"); } while (0)

#define XB_TMO      128
#define XB_XCNT(j)  (256  + 64 * (j))
#define XB_XSUB(j)  (1280 + 64 * (j))
#define XB_XGEN(j)  (2304 + 64 * (j))
#define XB_TOP      3328
#define XB_TOPGEN   3392
#define XCD_BAR_WORDS 3456
#define XB_SPIN_CAP (1u << 22)

__device__ __forceinline__ unsigned xb_ld(unsigned* p)              { return __hip_atomic_load(p, __ATOMIC_RELAXED, __HIP_MEMORY_SCOPE_AGENT); }
__device__ __forceinline__ unsigned xb_add(unsigned* p, unsigned v) { return __hip_atomic_fetch_add(p, v, __ATOMIC_RELAXED, __HIP_MEMORY_SCOPE_AGENT); }
__device__ __forceinline__ unsigned xb_xcc_id() { return (unsigned)__builtin_amdgcn_s_getreg((3 << 11) | 20) & 0xFu; }
#define XB_SPIN(cond, bar) do { unsigned _sp = 0; while (cond) { __builtin_amdgcn_s_sleep(1); \
    if ((++_sp & 255u) == 0u) { if (xb_ld(&(bar)[XB_TMO])) break; if (_sp > XB_SPIN_CAP) { atomicAdd(&(bar)[XB_TMO], 1u); break; } } } } while (0)

struct XcdBarrier {
    unsigned* bar; unsigned x;
    volatile LAS unsigned* st;
};

__device__ __forceinline__ XcdBarrier xcd_barrier_post(unsigned* bar, volatile LAS unsigned* st) {
    XcdBarrier b; b.bar = bar; b.x = xb_xcc_id(); b.st = st;
    if (threadIdx.x == 0) (void)xb_add(&bar[XB_XCNT(b.x)], 1u);
    return b;
}
__device__ __forceinline__ void xcd_barrier_complete(unsigned* bar, unsigned x, unsigned& nloc, unsigned& nx) {
    const unsigned G = gridDim.x * gridDim.y * gridDim.z;
    unsigned sum, cnt, mine, sp = 0u;
    for (;;) {
        sum = 0u; cnt = 0u; mine = 0u;
#pragma unroll
        for (unsigned j = 0; j < 16; ++j) { const unsigned c = xb_ld(&bar[XB_XCNT(j)]); sum += c; cnt += (c > 0u) ? 1u : 0u; mine = (j == x) ? c : mine; }
        if (sum == G) break;
        __builtin_amdgcn_s_sleep(1);
        if ((++sp & 255u) == 0u) { if (xb_ld(&bar[XB_TMO])) break; if (sp > XB_SPIN_CAP) { atomicAdd(&bar[XB_TMO], 1u); break; } }
    }
    nloc = mine > 0u ? mine : 1u; nx = cnt > 0u ? cnt : 1u;
}

__device__ __forceinline__ void xcd_barrier(const XcdBarrier& b) {
    asm volatile("s_waitcnt vmcnt(0)" ::: "memory");
    __syncthreads();
    if (threadIdx.x == 0) {
        unsigned* bar = b.bar;
        __builtin_amdgcn_s_waitcnt(0);
        unsigned nloc = b.st[0], nx = b.st[1];
        if (nloc == 0u) { xcd_barrier_complete(bar, b.x, nloc, nx); b.st[0] = nloc; b.st[1] = nx; }
        const unsigned old = xb_add(&bar[XB_XSUB(b.x)], 1u);
        const unsigned gen = old / nloc;
        if (old + 1u == (gen + 1u) * nloc) {
            __builtin_amdgcn_fence(__ATOMIC_RELEASE, "agent");
            asm volatile("s_waitcnt vmcnt(0)" ::: "memory");
            const unsigned og = xb_add(&bar[XB_TOP], 1u);
            const unsigned tg = og / nx;
            if (og + 1u == (tg + 1u) * nx) xb_add(&bar[XB_TOPGEN], 1u);
            else XB_SPIN(xb_ld(&bar[XB_TOPGEN]) == tg, bar);
            __builtin_amdgcn_fence(__ATOMIC_ACQUIRE, "agent");
            xb_add(&bar[XB_XGEN(b.x)], 1u);
            asm volatile("s_waitcnt vmcnt(0)" ::: "memory");
        } else {
            XB_SPIN(xb_ld(&bar[XB_XGEN(b.x)]) == gen, bar);
            __builtin_amdgcn_fence(__ATOMIC_ACQUIRE, "agent");
            asm volatile("s_waitcnt vmcnt(0)" ::: "memory");
        }
    }
    __syncthreads();
}

constexpr int TR_SCR = 64 * 65 * 4;
__device__ __forceinline__ void tr_item(const float* W, int K, int N, const float* gain, bf16_t* WT, int mode, LAS float* scr, int item, int lane) {
    const int nblk = N / 64, kb = item / nblk, nb = item % nblk, k0 = 64 * kb, n0 = 64 * nb;
    const int lr = lane >> 4, n4 = 4 * (lane & 15);
    f32x4 v[16]; float gk[16];
    const float* src = W + (size_t)(k0 + lr) * N + n0 + n4;
    if (gain) {
#pragma unroll
        for (int i = 0; i < 16; ++i) gk[i] = gain[k0 + 4 * i + lr];
    } else {
#pragma unroll
        for (int i = 0; i < 16; ++i) gk[i] = 1.0f;
    }
#pragma unroll
    for (int i = 0; i < 16; ++i) v[i] = *(const f32x4*)(src + (size_t)(4 * i) * N);
#pragma unroll
    for (int i = 0; i < 16; ++i) v[i] = v[i] * gk[i];
#pragma unroll
    for (int i = 0; i < 16; ++i) { LAS float* d = scr + (4 * i + lr) * 65 + n4; d[0] = v[i][0]; d[1] = v[i][1]; d[2] = v[i][2]; d[3] = v[i][3]; }
    asm volatile("s_waitcnt lgkmcnt(0)" ::: "memory");
    const int c = lane & 7;
#pragma unroll
    for (int j = 0; j < 8; ++j) { const int n = (lane >> 3) + 8 * j; const LAS float* s = scr + (8 * c) * 65 + n;
        u32x4 o; o.x = pk2(s[0 * 65], s[1 * 65]); o.y = pk2(s[2 * 65], s[3 * 65]); o.z = pk2(s[4 * 65], s[5 * 65]); o.w = pk2(s[6 * 65], s[7 * 65]);
        const int nn = n0 + n; const int dr = (mode == 0) ? nn : (256 * (nn >> 7) + (nn & 127) + (mode == 2 ? 128 : 0));
        *(u32x4*)(WT + (size_t)dr * K + k0 + 8 * c) = o; }
    asm volatile("s_waitcnt lgkmcnt(0)" ::: "memory");
}

struct Args { const float* in[21]; float* out; unsigned char* ws; };
enum { I_X = 0, I_F1N, I_F1G, I_F1U, I_F1D, I_MIXN, I_WIN, I_SGUN, I_SGUW, I_SGUB, I_LQ1, I_LK1, I_LQ2, I_LK2, I_SUBLN, I_WOUT, I_F2N, I_F2G, I_F2U, I_F2D, I_FINN };

constexpr int IT_GU = (DM / 64) * (DFF / 64), IT_D = (DFF / 64) * (DM / 64), IT_IN = (DM / 64) * (NIN / 64), IT_OUT = (DM / 64) * (DM / 64);
constexpr int IT_FFN = 2 * IT_GU + IT_D, IT_LAYER = 2 * IT_FFN + IT_IN + IT_OUT;
__device__ __forceinline__ void convert_items(const Args& a, LAS unsigned char* lds, int l, int it0, int it1, int w, int nw, int wave, int lane) {
    LAS float* scr = (LAS float*)(lds + wave * TR_SCR);
    unsigned char* wl = a.ws + WS_W + (size_t)l * L_STRIDE;
    for (int it = it0 + w; it < it1; it += nw) {
        int r = it;
        if (r < 2 * IT_FFN) {
            const int f = r / IT_FFN; r -= f * IT_FFN;
            const float* gn = a.in[f ? I_F2N : I_F1N] + (size_t)l * DM;
            bf16_t* wgu = (bf16_t*)(wl + (f ? LO_WGU2 : LO_WGU1)); bf16_t* wd = (bf16_t*)(wl + (f ? LO_WD2 : LO_WD1));
            if (r < IT_GU) tr_item(a.in[f ? I_F2G : I_F1G] + (size_t)l * DM * DFF, DM, DFF, gn, wgu, 1, scr, r, lane);
            else if (r < 2 * IT_GU) tr_item(a.in[f ? I_F2U : I_F1U] + (size_t)l * DM * DFF, DM, DFF, gn, wgu, 2, scr, r - IT_GU, lane);
            else tr_item(a.in[f ? I_F2D : I_F1D] + (size_t)l * DFF * DM, DFF, DM, nullptr, wd, 0, scr, r - 2 * IT_GU, lane);
        } else {
            r -= 2 * IT_FFN;
            if (r < IT_IN) tr_item(a.in[I_WIN] + (size_t)l * DM * NIN, DM, NIN, a.in[I_MIXN] + (size_t)l * DM, (bf16_t*)(wl + LO_WIN), 0, scr, r, lane);
            else tr_item(a.in[I_WOUT] + (size_t)l * DM * DM, DM, DM, nullptr, (bf16_t*)(wl + LO_WOUT), 0, scr, r - IT_IN, lane);
        }
    }
}
__device__ __forceinline__ bool slot_range(int l, int slot, int& layer, int& s0, int& s1) {
    if (l == 0) { if (slot == 0) { layer = 0; s0 = 2 * IT_GU; s1 = IT_LAYER; } else { layer = 1; s0 = (slot - 1) * (IT_LAYER / 2); s1 = slot * (IT_LAYER / 2); } return true; }
    if (l + 1 >= DEPTH) return false;
    layer = l + 1; s0 = (IT_LAYER * slot) / 3; s1 = (IT_LAYER * (slot + 1)) / 3; return true;
}
__device__ __forceinline__ void prologue(const Args& a, LAS unsigned char* lds, int vcu, int G, int wave, int lane) {
    const int gw = vcu * NWAVES + wave, NGW = G * NWAVES;
    if (G == 256) convert_items(a, lds, 0, 0, 2 * IT_GU, gw, NGW, wave, lane);
    else for (int l = 0; l < DEPTH; ++l) convert_items(a, lds, l, 0, IT_LAYER, gw, NGW, wave, lane);
    {
        const int gt = vcu * NTHREADS + wave * 64 + lane, NT = G * NTHREADS;
        for (int i = gt; i < DEPTH * 8 * 128 * 128 / 4; i += NT) {
            const int e0 = i * 4, l = e0 >> 17, rem = e0 & 131071, t = (rem >> 7) & 127, s0 = rem & 127;
            const f32x4 w = *(const f32x4*)(a.in[I_SGUW] + e0);
            u32x2 o; o.x = pk2(s0 + 0 <= t ? w[0] : 0.f, s0 + 1 <= t ? w[1] : 0.f); o.y = pk2(s0 + 2 <= t ? w[2] : 0.f, s0 + 3 <= t ? w[3] : 0.f);
            *(u32x2*)((bf16_t*)(a.ws + WS_W + (size_t)l * L_STRIDE + LO_SGUW) + rem) = o;
        }
    }
    {
        const float* x = a.in[I_X]; bf16_t* XB = (bf16_t*)(a.ws + WS_XB); float* rs = (float*)(a.ws + WS_RS);
        for (int m0 = 2 * gw; m0 < M; m0 += 2 * NGW) {
            f32x4 v[2][4];
#pragma unroll
            for (int q = 0; q < 2; ++q)
#pragma unroll
                for (int j = 0; j < 4; ++j) v[q][j] = ((const f32x4*)(x + (size_t)(m0 + q) * DM) + lane)[64 * j];
#pragma unroll
            for (int q = 0; q < 2; ++q) {
                const int m = m0 + q; float s = 0.f;
#pragma unroll
                for (int j = 0; j < 4; ++j) s += (v[q][j][0] * v[q][j][0] + v[q][j][1] * v[q][j][1]) + (v[q][j][2] * v[q][j][2] + v[q][j][3] * v[q][j][3]);
                s = wave_sum(s);
                u32x2* bo = (u32x2*)(XB + (size_t)m * DM) + lane;
#pragma unroll
                for (int j = 0; j < 4; ++j) { u32x2 o; o.x = pk2(v[q][j][0], v[q][j][1]); o.y = pk2(v[q][j][2], v[q][j][3]); bo[64 * j] = o; }
                if (lane < 16) rs[(size_t)m * 16 + lane] = (lane == 0) ? s : 0.f;
            }
        }
    }
}

__device__ __forceinline__ void sgu_unit(LAS unsigned char* lds, const bf16_t* Z, const bf16_t* Wb, const float* ngain, const float* bias, bf16_t* Y, int b, int c, int g) {
    int tid_ = threadIdx.x; asm volatile("" : "+v"(tid_));
    const int tid = tid_, lane = tid & 63, wid = __builtin_amdgcn_readfirstlane(tid >> 6), r32 = lane & 31, hi = lane >> 5;
    const size_t rowbase = (size_t)b * SEQ + (size_t)c * 128;
    bf16x8 wf[8]; u32x2 uu[4]; float bs;
    {
        const int dc_ = wid & 1, tc_ = wid >> 1, t_ = 32 * tc_ + r32;
        const bf16_t* bp_ = Wb + (size_t)t_ * 128 + 8 * hi;
#pragma unroll
        for (int kk = 0; kk < 8; ++kk) wf[kk] = *(const bf16x8*)(bp_ + 16 * kk);
        const bf16_t* up_ = Z + (rowbase + t_) * 1024 + g * 64 + 32 * dc_ + 4 * hi;
#pragma unroll
        for (int j = 0; j < 4; ++j) uu[j] = *(const u32x2*)(up_ + 8 * j);
        bs = bias[t_];
    }
    const f32x4 ng0 = *(const f32x4*)(ngain + (tid & 7) * 8), ng1 = *(const f32x4*)(ngain + (tid & 7) * 8 + 4);
#pragma unroll
    for (int i = 0; i < 2; ++i) {
        const int cid = tid + 512 * i, s = cid >> 3, ch = cid & 7;
        const u32x4 raw = *(const u32x4*)(Z + (rowbase + s) * 1024 + 512 + g * 64 + ch * 8);
        float v[8]; v[0] = bflo(raw.x); v[1] = bfhi(raw.x); v[2] = bflo(raw.y); v[3] = bfhi(raw.y); v[4] = bflo(raw.z); v[5] = bfhi(raw.z); v[6] = bflo(raw.w); v[7] = bfhi(raw.w);
        float ss = 0.f;
#pragma unroll
        for (int e = 0; e < 8; ++e) ss += v[e] * v[e];
        ss += __builtin_bit_cast(float, __builtin_amdgcn_update_dpp(0, __builtin_bit_cast(int, ss), 0xB1, 0xF, 0xF, false));
        ss += __builtin_bit_cast(float, __builtin_amdgcn_update_dpp(0, __builtin_bit_cast(int, ss), 0x4E, 0xF, 0xF, false));
        ss += __builtin_bit_cast(float, __builtin_amdgcn_update_dpp(0, __builtin_bit_cast(int, ss), 0x141, 0xF, 0xF, false));
        const float rstd = __builtin_amdgcn_rsqf(ss * (1.0f / 64.0f) + 1e-6f);
        const float gg[8] = {ng0[0], ng0[1], ng0[2], ng0[3], ng1[0], ng1[1], ng1[2], ng1[3]};
        const int pc = ((s >> 3) ^ ch) * 16 + (s & 7) * 2;
#pragma unroll
        for (int e = 0; e < 8; ++e) *(LAS unsigned short*)(lds + (ch * 8 + e) * 272 + pc) = (unsigned short)f2bf(v[e] * rstd * gg[e]);
    }
    WG_BAR();
    const int dc = wid & 1, tc = wid >> 1;
    f32x16 acc;
#pragma unroll
    for (int r = 0; r < 16; ++r) acc[r] = 0.f;
    const int d = 32 * dc + r32, t = 32 * tc + r32;
    const LAS unsigned char* ap = lds + d * 272; const int dsw = (d >> 3) & 7;
    const bf16_t* bp = Wb + (size_t)t * 128 + 8 * hi;
    bf16x8 af[8];
#pragma unroll
    for (int kk = 0; kk < 8; ++kk) af[kk] = *(const LAS bf16x8*)(ap + (((2 * kk + hi) ^ dsw) * 16));
#pragma unroll
    for (int kk = 0; kk < 8; ++kk) {
        if (kk < 2 * tc + 2) acc = __builtin_amdgcn_mfma_f32_32x32x16_bf16(af[kk], wf[kk], acc, 0, 0, 0);
    }
    bf16_t* yp = Y + (rowbase + t) * 1024 + g * 64 + 32 * dc + 4 * hi;
#pragma unroll
    for (int j = 0; j < 4; ++j) {
        u32x2 o; o.x = cvtpk(bflo(uu[j].x) * (acc[4 * j + 0] + bs), bfhi(uu[j].x) * (acc[4 * j + 1] + bs)); o.y = cvtpk(bflo(uu[j].y) * (acc[4 * j + 2] + bs), bfhi(uu[j].y) * (acc[4 * j + 3] + bs));
        *(u32x2*)(yp + 8 * j) = o;
    }
    WG_BAR();
}

namespace att {
constexpr float ATT_THR = 8.0f;
constexpr int KSTR = 144, K_BYTES = 64 * KSTR, V_BYTES = 128 * KSTR, STAGE = 2 * K_BYTES + V_BYTES, NSTG = 3, COMB_OFF = 0;
static_assert(NSTG * STAGE <= LDS_BYTES - 64 && COMB_OFF + 65536 <= NSTG * STAGE, "attention LDS");
}
__device__ __forceinline__ void attn_scores(const LAS unsigned char* sb, int kt, int qabs, int map, int pir, int hi, float cb, float mref, const bf16x8 (&qf)[4], f32x16& p0, f32x16& p1) {
    using namespace att;
    const LAS unsigned char* kp = sb + map * K_BYTES + pir * KSTR + hi * 16;
    const float lb0 = cb * (float)(64 * kt + 8 * hi - qabs) - mref, lb1 = lb0 + cb * 32.0f;
#pragma unroll
    for (int r = 0; r < 16; ++r) { const float kc = (float)(16 * (r >> 3) + (r & 7)); p0[r] = __builtin_fmaf(cb, kc, lb0); p1[r] = __builtin_fmaf(cb, kc, lb1); }
#pragma unroll
    for (int hb = 0; hb < 2; ++hb) {
        bf16x8 kf[4];
#pragma unroll
        for (int d = 0; d < 2; ++d) { kf[2 * d] = *(const LAS bf16x8*)(kp + (2 * hb + d) * 32); kf[2 * d + 1] = *(const LAS bf16x8*)(kp + 32 * KSTR + (2 * hb + d) * 32); }
        __builtin_amdgcn_sched_barrier(0);
        __builtin_amdgcn_s_setprio(1);
#pragma unroll
        for (int d = 0; d < 2; ++d) {
            p0 = __builtin_amdgcn_mfma_f32_32x32x16_bf16(kf[2 * d], qf[2 * hb + d], p0, 0, 0, 0);
            p1 = __builtin_amdgcn_mfma_f32_32x32x16_bf16(kf[2 * d + 1], qf[2 * hb + d], p1, 0, 0, 0);
        }
        __builtin_amdgcn_s_setprio(0);
        __builtin_amdgcn_sched_barrier(0);
    }
}
__device__ __forceinline__ void attn_softmax(int kt, int qb, int qabs, int hi, f32x16& p0, f32x16& p1, f32x16 (&o)[4], float& mref, float& lrun, bool& mset, bf16x8 (&pf)[4]) {
    using namespace att;
    if (kt >= 2 * qb) {
        const int kbase = 64 * kt + 8 * hi;
#pragma unroll
        for (int r = 0; r < 16; ++r) { const int key = kbase + 16 * (r >> 3) + (r & 7); if (key > qabs) p0[r] = -1e30f; if (key + 32 > qabs) p1[r] = -1e30f; }
    }
    asm volatile("s_nop 15\n\ts_nop 7" : "+v"(p0), "+v"(p1));
    float mx, mx2;
    asm("v_max3_f32 %0, %1, %2, %3" : "=v"(mx) : "v"(p0[0]), "v"(p1[0]), "v"(p0[1]));
    asm("v_max3_f32 %0, %1, %2, %3" : "=v"(mx2) : "v"(p1[1]), "v"(p0[2]), "v"(p1[2]));
#pragma unroll
    for (int r = 3; r < 15; r += 2) {
        asm("v_max3_f32 %0, %1, %2, %3" : "=v"(mx) : "v"(mx), "v"(p0[r]), "v"(p1[r]));
        asm("v_max3_f32 %0, %1, %2, %3" : "=v"(mx2) : "v"(mx2), "v"(p0[r + 1]), "v"(p1[r + 1]));
    }
    asm("v_max3_f32 %0, %1, %2, %3" : "=v"(mx) : "v"(mx), "v"(p0[15]), "v"(p1[15]));
    asm("v_max3_f32 %0, %1, %2, %3" : "=v"(mx) : "v"(mx), "v"(mx2), "v"(mx2));
    { const auto rr = __builtin_amdgcn_permlane32_swap(__builtin_bit_cast(unsigned, mx), __builtin_bit_cast(unsigned, mx), false, false);
      const float ma = __builtin_bit_cast(float, (unsigned)rr[0]), mb = __builtin_bit_cast(float, (unsigned)rr[1]); asm("v_max3_f32 %0, %1, %2, %3" : "=v"(mx) : "v"(ma), "v"(mb), "v"(mb)); }
    const bool need = mset ? (mx > ATT_THR) : (mx > -1e29f);
    if (__any(need)) {
        const float delta = need ? mx : 0.f, f = (need && mset) ? __builtin_amdgcn_exp2f(-delta) : 1.0f;
        mref += delta; mset = mset || need; lrun *= f;
#pragma unroll
        for (int r = 0; r < 16; ++r) { p0[r] -= delta; p1[r] -= delta; }
#pragma unroll
        for (int c = 0; c < 4; ++c)
#pragma unroll
            for (int r = 0; r < 16; ++r) o[c][r] *= f;
    }
    float ps = 0.f;
#pragma unroll
    for (int r = 0; r < 16; ++r) { p0[r] = __builtin_amdgcn_exp2f(p0[r]); p1[r] = __builtin_amdgcn_exp2f(p1[r]); ps += p0[r] + p1[r]; }
    lrun += ps;
    u32x4 w;
    w.x = cvtpk(p0[0], p0[1]); w.y = cvtpk(p0[2], p0[3]); w.z = cvtpk(p0[4], p0[5]); w.w = cvtpk(p0[6], p0[7]); pf[0] = __builtin_bit_cast(bf16x8, w);
    w.x = cvtpk(p0[8], p0[9]); w.y = cvtpk(p0[10], p0[11]); w.z = cvtpk(p0[12], p0[13]); w.w = cvtpk(p0[14], p0[15]); pf[1] = __builtin_bit_cast(bf16x8, w);
    w.x = cvtpk(p1[0], p1[1]); w.y = cvtpk(p1[2], p1[3]); w.z = cvtpk(p1[4], p1[5]); w.w = cvtpk(p1[6], p1[7]); pf[2] = __builtin_bit_cast(bf16x8, w);
    w.x = cvtpk(p1[8], p1[9]); w.y = cvtpk(p1[10], p1[11]); w.z = cvtpk(p1[12], p1[13]); w.w = cvtpk(p1[14], p1[15]); pf[3] = __builtin_bit_cast(bf16x8, w);
}
__device__ __forceinline__ void attn_pv(const LAS unsigned char* sb, int r32, int hi, const bf16x8 (&pf)[4], f32x16 (&o)[4]) {
    using namespace att;
    const LAS unsigned char* vp = sb + 2 * K_BYTES + r32 * KSTR + hi * 16;
#pragma unroll
    for (int kq = 0; kq < 4; ++kq) {
        bf16x8 vf[4];
#pragma unroll
        for (int c = 0; c < 4; ++c) vf[c] = *(const LAS bf16x8*)(vp + c * 32 * KSTR + kq * 32);
        __builtin_amdgcn_sched_barrier(0);
        __builtin_amdgcn_s_setprio(1);
#pragma unroll
        for (int c = 0; c < 4; ++c) o[c] = __builtin_amdgcn_mfma_f32_32x32x16_bf16(vf[c], pf[kq], o[c], 0, 0, 0);
        __builtin_amdgcn_s_setprio(0);
        __builtin_amdgcn_sched_barrier(0);
    }
}
__device__ __forceinline__ void attn_step(const LAS unsigned char* sb, const LAS unsigned char* sb_prev, int kt, int qb, int qabs, int qmax_w, int map, int pir, int r32, int hi, float cb, const bf16x8 (&qf)[4],
                                          f32x16 (&o)[4], float& mref, float& lrun, bool& mset, bf16x8 (&pf)[4], bool& pend) {
    const bool have = 64 * kt <= qmax_w;
    f32x16 p0, p1;
    if (pend) attn_pv(sb_prev, r32, hi, pf, o);
    pend = false;
    if (have) {
        attn_scores(sb, kt, qabs, map, pir, hi, cb, mref, qf, p0, p1);
        attn_softmax(kt, qb, qabs, hi, p0, p1, o, mref, lrun, mset, pf);
        if (map == 0) attn_pv(sb, r32, hi, pf, o); else pend = true;
    }
}
#define LBAR() do { asm volatile("s_waitcnt lgkmcnt(0)" ::: "memory"); __builtin_amdgcn_s_barrier(); asm volatile("" ::: "memory"); } while (0)
__device__ __forceinline__ void attn_unit(LAS unsigned char* lds, const bf16_t* Q, const bf16_t* Kg, const bf16_t* Vt, bf16_t* Y, int b, int h, int qb, float cb, float lam, const float* subgain, float outscale) {
    using namespace att;
    int tid_ = threadIdx.x; asm volatile("" : "+v"(tid_));
    const int tid = tid_, lane = tid & 63, wid = __builtin_amdgcn_readfirstlane(tid >> 6), map = wid >> 2, g = wid & 3, r32 = lane & 31, hi = lane >> 5;
    const size_t rowbase = (size_t)b * SEQ; const int q0 = qb * 128, qabs = q0 + 32 * g + r32;
    const int nt = 2 * qb + 2;
    const int krow = tid >> 4, kch = tid & 15, vrow = tid >> 3, vch = tid & 7;
    const bf16_t* kg = Kg + (rowbase + krow) * 512 + h * 128 + kch * 8;
    const bf16_t* vg = Vt + ((size_t)(b * 4 + h) * 128 + vrow) * 2048 + vch * 8;
    const int klds = (kch >> 3) * K_BYTES + krow * KSTR + (kch & 7) * 16, vlds = 2 * K_BYTES + vrow * KSTR + vch * 16;
    u32x4 Ak0, Ak1, Av0, Av1, Bk0, Bk1, Bv0, Bv1;
#define ATT_GLOAD(S, j) do { const int kt_ = (nt - 1 - (j)) > 0 ? (nt - 1 - (j)) : 0; \
                              S##k0 = *(const u32x4*)(kg + (size_t)kt_ * 64 * 512); S##k1 = *(const u32x4*)(kg + (size_t)kt_ * 64 * 512 + 32 * 512); \
                              S##v0 = *(const u32x4*)(vg + kt_ * 64); S##v1 = *(const u32x4*)(vg + kt_ * 64 + (size_t)64 * 2048); } while (0)
#define ATT_LSTORE(S, sb_) do { *(LAS u32x4*)((sb_) + klds) = S##k0; *(LAS u32x4*)((sb_) + klds + 32 * KSTR) = S##k1; \
                                *(LAS u32x4*)((sb_) + vlds) = S##v0; *(LAS u32x4*)((sb_) + vlds + 64 * KSTR) = S##v1; } while (0)
    bf16x8 qf[4];
    { const bf16_t* qp = Q + (rowbase + qabs) * 512 + h * 128 + map * 64 + hi * 8;
#pragma unroll
      for (int d0 = 0; d0 < 4; ++d0) qf[d0] = *(const bf16x8*)(qp + d0 * 16); }
    ATT_GLOAD(A, 0); ATT_GLOAD(B, 1);
    __builtin_amdgcn_s_waitcnt(0x0F74);
    f32x16 o[4];
#pragma unroll
    for (int c = 0; c < 4; ++c)
#pragma unroll
        for (int r = 0; r < 16; ++r) o[c][r] = 0.f;
    float mref = 0.f, lrun = 0.f; bool mset = false, pend = false;
    bf16x8 pf[4];
#pragma unroll
    for (int i = 0; i < 4; ++i) pf[i] = (bf16x8){0, 0, 0, 0, 0, 0, 0, 0};
    const int pir = (r32 & 19) | ((r32 & 4) << 1) | ((r32 & 8) >> 1);
    const int qmax_w = q0 + 32 * g + 31;
    LAS unsigned char* s_prev = lds + 2 * STAGE; LAS unsigned char* s_cur = lds; LAS unsigned char* s_next = lds + STAGE;
#define ATT_ROT() do { LAS unsigned char* t_ = s_prev; s_prev = s_cur; s_cur = s_next; s_next = t_; } while (0)
    ATT_LSTORE(A, s_cur); LBAR();
    for (int j = 0; j < nt; j += 2) {
        ATT_GLOAD(A, j + 2);
        attn_step(s_cur, s_prev, nt - 1 - j, qb, qabs, qmax_w, map, pir, r32, hi, cb, qf, o, mref, lrun, mset, pf, pend);
        ATT_LSTORE(B, s_next); LBAR(); ATT_ROT();
        ATT_GLOAD(B, j + 3);
        attn_step(s_cur, s_prev, nt - 2 - j, qb, qabs, qmax_w, map, pir, r32, hi, cb, qf, o, mref, lrun, mset, pf, pend);
        ATT_LSTORE(A, s_next); LBAR(); ATT_ROT();
    }
    if (map == 1 && pend) attn_pv(s_prev, r32, hi, pf, o);
    LBAR();
#undef ATT_ROT
#undef ATT_GLOAD
#undef ATT_LSTORE
    const float ltot = lrun + __shfl_xor(lrun, 32), inv = 1.0f / ltot;
    LAS float* comb = (LAS float*)(lds + COMB_OFF) + g * 4096 + r32;
    if (map == 1) {
        const float f = lam * inv;
#pragma unroll
        for (int c = 0; c < 4; ++c)
#pragma unroll
            for (int r = 0; r < 16; ++r) comb[(32 * c + (r & 3) + 8 * (r >> 2) + 4 * hi) * 32] = o[c][r] * f;
    }
    f32x4 gn[16];
#pragma unroll
    for (int c = 0; c < 4; ++c)
#pragma unroll
        for (int j = 0; j < 4; ++j) gn[c * 4 + j] = *(const f32x4*)(subgain + 32 * c + 8 * j + 4 * hi);
    LBAR();
    if (map == 0) {
        float ss = 0.f;
#pragma unroll
        for (int c = 0; c < 4; ++c)
#pragma unroll
            for (int r = 0; r < 16; ++r) { const float v = o[c][r] * inv - comb[(32 * c + (r & 3) + 8 * (r >> 2) + 4 * hi) * 32]; o[c][r] = v; ss += v * v; }
        ss += __shfl_xor(ss, 32);
        const float rstd = __builtin_amdgcn_rsqf(ss * (1.0f / 128.0f) + 1e-6f) * outscale;
        bf16_t* yp = Y + (rowbase + qabs) * 1024 + 512 + h * 128 + 4 * hi;
#pragma unroll
        for (int c = 0; c < 4; ++c)
#pragma unroll
            for (int j = 0; j < 4; ++j) {
                const f32x4 gq = gn[c * 4 + j];
                u32x2 w; w.x = cvtpk(o[c][4 * j + 0] * rstd * gq[0], o[c][4 * j + 1] * rstd * gq[1]); w.y = cvtpk(o[c][4 * j + 2] * rstd * gq[2], o[c][4 * j + 3] * rstd * gq[3]);
                *(u32x2*)(yp + 32 * c + 8 * j) = w;
            }
    }
    LBAR();
}

__global__ void __launch_bounds__(NTHREADS, 2) hybrid_fwd(Args a) {
    extern __shared__ __attribute__((aligned(16))) unsigned char lds_raw[];
    LAS unsigned char* lds = (LAS unsigned char*)lds_raw;
    cg::grid_group grid = cg::this_grid();
    const int G = gridDim.x, bx = blockIdx.x, vcu = (G % 8 == 0) ? (bx % 8) * (G / 8) + bx / 8 : bx;
    unsigned char* ws = a.ws;
    if (threadIdx.x < 16) ((LAS unsigned*)(lds + LDS_BYTES - 64))[threadIdx.x] = 0u;
    __syncthreads();
    const XcdBarrier bar = xcd_barrier_post((unsigned*)(ws + WS_CTL), (volatile LAS unsigned*)(lds + LDS_BYTES - 64));
    float* X = (float*)(ws + WS_X); bf16_t* XB = (bf16_t*)(ws + WS_XB); float* RS = (float*)(ws + WS_RS);
    bf16_t* ACT = (bf16_t*)(ws + WS_ACT); bf16_t* Zb = (bf16_t*)(ws + WS_Z); bf16_t* Qb = (bf16_t*)(ws + WS_Q); bf16_t* Kb = (bf16_t*)(ws + WS_K); bf16_t* Vtb = (bf16_t*)(ws + WS_VT); bf16_t* Yb = (bf16_t*)(ws + WS_Y);

#ifndef NO_PRO
    for (int rep_ = 0; rep_ < PROBE_PRO_REPS; ++rep_) { int t_ = threadIdx.x; asm volatile("" : "+v"(t_)); prologue(a, lds, vcu, G, __builtin_amdgcn_readfirstlane(t_ >> 6), t_ & 63); }
#endif
    grid.sync();
    xcd_barrier(bar);

#pragma unroll 1
    for (int st = 0; st < 3 * DEPTH; ++st) {
        const int l = st / 3, sub = st - 3 * l;
        unsigned char* wl = ws + WS_W + (size_t)l * L_STRIDE;
        const float* rs_in = RS + (size_t)(st & 1) * M * 16; float* rs_out = RS + (size_t)((st + 1) & 1) * M * 16;
        if (sub != 1) {
            for (int rep_ = 0; rep_ < PROBE_G1_REPS; ++rep_) {
                pg8::Gemm gm{XB, (const bf16_t*)(wl + (sub ? LO_WGU2 : LO_WGU1)), M, 2 * DFF, DM}; pg8::StaticOrder S; S.init(M, 2 * DFF, G, bx);
                pg8::EpiSwiglu E{ACT, DFF, rs_in};
#ifndef NO_G1
                pg8::gemm_phase<pg8::EpiSwiglu, pg8::StaticOrder, true, true>(lds, gm, S, E);
#endif
                int cl_ = 0, s0_ = 0, s1_ = 0;
                if (G == 256 && bx >= 128 && slot_range(l, sub ? 2 : 0, cl_, s0_, s1_)) {
                    int t_ = threadIdx.x; asm volatile("" : "+v"(t_));
                    convert_items(a, lds, cl_, s0_, s1_, (bx - 128) * NWAVES + __builtin_amdgcn_readfirstlane(t_ >> 6), 128 * NWAVES, __builtin_amdgcn_readfirstlane(t_ >> 6), t_ & 63);
                }
            }
            for (int rb_ = 0; rb_ < PROBE_BAR_REPS; ++rb_) xcd_barrier(bar);
            {
                pg8::Gemm gm{ACT, (const bf16_t*)(wl + (sub ? LO_WD2 : LO_WD1)), M, DM, DFF}; pg8::StaticOrder S; S.init(M, DM, G, bx);
                pg8::EpiResid E{st == 0 ? a.in[I_X] : (const float*)X, X, XB, rs_out, 0.5f};
#ifndef NO_G2
                pg8::gemm_phase<pg8::EpiResid, pg8::StaticOrder, true, true>(lds, gm, S, E);
#endif
            }
            for (int rb_ = 0; rb_ < PROBE_BAR_REPS; ++rb_) xcd_barrier(bar);
        } else {
            for (int rep_ = 0; rep_ < PROBE_G3_REPS; ++rep_) {
                pg8::Gemm gm{XB, (const bf16_t*)(wl + LO_WIN), M, NIN, DM}; pg8::StaticOrder S; S.init(M, NIN, G, bx);
                pg8::EpiWin E{Zb, Qb, Kb, Vtb, rs_in, 0.125f * 1.4426950408889634f};
#ifndef NO_G3
                pg8::gemm_phase<pg8::EpiWin, pg8::StaticOrder, true, true>(lds, gm, S, E);
#endif
                int cl_ = 0, s0_ = 0, s1_ = 0;
                if (G == 256 && bx >= 128 && slot_range(l, 1, cl_, s0_, s1_)) {
                    int t_ = threadIdx.x; asm volatile("" : "+v"(t_));
                    convert_items(a, lds, cl_, s0_, s1_, (bx - 128) * NWAVES + __builtin_amdgcn_readfirstlane(t_ >> 6), 128 * NWAVES, __builtin_amdgcn_readfirstlane(t_ >> 6), t_ & 63);
                }
            }
            for (int rb_ = 0; rb_ < PROBE_BAR_REPS; ++rb_) xcd_barrier(bar);
            for (int rep_ = 0; rep_ < PROBE_MIX_REPS; ++rep_) {
                const bf16_t* sw = (const bf16_t*)(wl + LO_SGUW);
                for (int rs_ = 0; rs_ < PROBE_SGU_REPS; ++rs_)
                for (int ui = vcu; ui < NB * 16 * 8; ui += G) {
                    const int g = ui & 7, c = (ui >> 3) & 15, b = ui >> 7;
#ifndef NO_SGU
                    sgu_unit(lds, Zb, sw + (size_t)g * 128 * 128, a.in[I_SGUN] + (size_t)l * 512 + g * 64, a.in[I_SGUB] + (size_t)l * 1024 + g * 128, Yb, b, c, g);
#endif
                }
                int t_ = threadIdx.x; asm volatile("" : "+v"(t_)); const int lane = t_ & 63;
                float lam_init = 0.8f - 0.6f * expf(-0.3f * (float)l);
                const float d1 = wave_sum(a.in[I_LQ1][l * 64 + lane] * a.in[I_LK1][l * 64 + lane]), d2 = wave_sum(a.in[I_LQ2][l * 64 + lane] * a.in[I_LK2][l * 64 + lane]);
                const float lam = expf(d1) - expf(d2) + lam_init;
                for (int ra_ = 0; ra_ < PROBE_ATT_REPS; ++ra_)
                for (int pi = vcu; pi < NB * 4 * 8; pi += G) {
                    const int bh = pi >> 3, s = pi & 7, b = bh >> 2, h = bh & 3;
                    const float cb = exp2f(-2.0f * (float)(h + 1)) * 1.4426950408889634f;
#pragma unroll 1
                    for (int i = 0; i < 2; ++i)
                    {
#ifndef NO_ATT
                        attn_unit(lds, Qb, Kb, Vtb, Yb, b, h, i ? 15 - s : s, cb, lam, a.in[I_SUBLN] + (size_t)l * 128, 1.0f - lam_init);
#endif
                    }
                }
            }
            for (int rb_ = 0; rb_ < PROBE_BAR_REPS; ++rb_) xcd_barrier(bar);
            {
                pg8::Gemm gm{Yb, (const bf16_t*)(wl + LO_WOUT), M, DM, DM}; pg8::StaticOrder S; S.init(M, DM, G, bx);
                pg8::EpiResid E{X, X, XB, rs_out, 1.0f};
#ifndef NO_G4
                pg8::gemm_phase<pg8::EpiResid, pg8::StaticOrder, true, true>(lds, gm, S, E);
#endif
            }
            for (int rb_ = 0; rb_ < PROBE_BAR_REPS; ++rb_) xcd_barrier(bar);
        }
    }
    {
        int t_ = threadIdx.x; asm volatile("" : "+v"(t_)); const int lane = t_ & 63, wave = __builtin_amdgcn_readfirstlane(t_ >> 6);
        const float* rs = RS; const float* fg = a.in[I_FINN];
        const int gw = vcu * NWAVES + wave, NGW = G * NWAVES;
        f32x4 gn[4];
#pragma unroll
        for (int j = 0; j < 4; ++j) gn[j] = *((const f32x4*)fg + lane + 64 * j);
        for (int m0 = 2 * gw; m0 < M; m0 += 2 * NGW) {
            f32x4 pv[2][4], xv[2][4];
#pragma unroll
            for (int q = 0; q < 2; ++q)
#pragma unroll
                for (int j = 0; j < 4; ++j) { pv[q][j] = *(const f32x4*)(rs + (size_t)(m0 + q) * 16 + 4 * j); xv[q][j] = ((const f32x4*)(X + (size_t)(m0 + q) * DM) + lane)[64 * j]; }
#pragma unroll
            for (int q = 0; q < 2; ++q) {
                float sq = 0.f;
#pragma unroll
                for (int j = 0; j < 4; ++j) sq += (pv[q][j][0] + pv[q][j][1]) + (pv[q][j][2] + pv[q][j][3]);
                const float r = __builtin_amdgcn_rsqf(sq * (1.0f / 1024.0f) + 1e-6f);
                f32x4* orow = (f32x4*)(a.out + (size_t)(m0 + q) * DM) + lane;
#pragma unroll
                for (int j = 0; j < 4; ++j) orow[64 * j] = xv[q][j] * r * gn[j];
            }
        }
    }
}

extern "C" void kernel_launch(void* const* d_in, const int* in_sizes, int n_in, void* d_out, int out_size, void* d_ws, size_t ws_size, hipStream_t stream) {
    static int grid = 0;
    if (grid == 0) {
        if (n_in != 21 || out_size != M * DM || ws_size < WS_END) { fprintf(stderr, "kernel_launch: unexpected problem (n_in %d, out %d, ws %zu, need %zu)\n", n_in, out_size, ws_size, (size_t)WS_END); grid = -1; return; }
        int dev = 0, cus = 0, per_cu = 0;
        hipGetDevice(&dev); hipDeviceGetAttribute(&cus, hipDeviceAttributeMultiprocessorCount, dev);
        if (hipFuncSetAttribute((const void*)hybrid_fwd, hipFuncAttributeMaxDynamicSharedMemorySize, LDS_BYTES) != hipSuccess) { fprintf(stderr, "kernel_launch: hipFuncSetAttribute failed\n"); grid = -1; return; }
        if (hipOccupancyMaxActiveBlocksPerMultiprocessor(&per_cu, (const void*)hybrid_fwd, NTHREADS, LDS_BYTES) != hipSuccess || per_cu < 1) { fprintf(stderr, "kernel_launch: occupancy query says %d\n", per_cu); per_cu = 1; }
        (void)hipGetLastError();
        grid = cus * per_cu;
    }
    if (grid < 0) return;
    if (hipMemsetAsync((unsigned char*)d_ws + WS_CTL, 0, CTL_BYTES, stream) != hipSuccess) { fprintf(stderr, "kernel_launch: memset failed\n"); return; }
    Args a{};
    for (int i = 0; i < 21; ++i) a.in[i] = (const float*)d_in[i];
    a.out = (float*)d_out; a.ws = (unsigned char*)d_ws;
    void* args[] = {&a};
    hipError_t e = hipLaunchCooperativeKernel((const void*)hybrid_fwd, dim3(grid), dim3(NTHREADS), args, LDS_BYTES, stream);
    if (e != hipSuccess) fprintf(stderr, "cooperative launch failed: %s (grid %d)\n", hipGetErrorString(e), grid);
}
```

```cpp
#include <hip/hip_runtime.h>
#include <hip/hip_cooperative_groups.h>
#include <cstdio>
#include <cstdint>
namespace cg = cooperative_groups;
namespace pg8 {
#define PG8_LAS __attribute__((address_space(3)))
typedef unsigned short bf16_t;
typedef short bf16x8 __attribute__((ext_vector_type(8)));
typedef float f32x4 __attribute__((ext_vector_type(4)));
typedef unsigned u32x4 __attribute__((ext_vector_type(4)));
constexpr int BM = 256, BK = 64, HALF = 128, HTB = HALF * BK * 2  , STAGE_BYTES = 8 * HTB, NXCD = 8, WGM = 8;

__host__ __device__ __forceinline__ int lds_byte(int r, int c) { const int st = (r >> 4) * 2 + (c >> 5), rr = r & 15, cc = c & 31, ob = rr * 64 + cc * 2; return st * 1024 + (ob ^ (((ob >> 9) & 1) << 5)); }
__host__ __device__ __forceinline__ void stage_rc(int b, int& R, int& C) { const int st = b / 1024, sb = b % 1024, swz = sb ^ (((sb >> 9) & 1) << 5); R = (st >> 1) * 16 + swz / 64; C = (st & 1) * 32 + (swz % 64) / 2; }
__host__ __device__ __forceinline__ int perm32(int rho) { const int n = rho >> 4, i = rho & 15; return 8 * (i >> 2) + 4 * n + (i & 3); }

struct Unit { int pm, pn; };
struct Gemm { const bf16_t* A; const bf16_t* Bt; int M, N, K; };

struct StaticOrder {
    int nM, nN, nwg, G, c;
    __host__ __device__ void init(int M, int N, int G_, int c_) { nM = M / BM; nN = N / BM; nwg = nM * nN; G = G_; c = c_; }
    __host__ __device__ bool next(int i, Unit& u) const {
        const long L = (long)i * G + c; if (L >= nwg) return false;
        int wgid = (int)L; { const int q = nwg / NXCD, r = nwg % NXCD, xcd = wgid % NXCD, off = wgid / NXCD; wgid = (xcd < r ? xcd * (q + 1) : r * (q + 1) + (xcd - r) * q) + off; }
        const int nig = WGM * nN, gid = wgid / nig, fm = gid * WGM, gsz = (nM - fm) < WGM ? (nM - fm) : WGM;
        u.pm = fm + ((wgid % nig) % gsz); u.pn = (wgid % nig) / gsz; return true;
    }
    __device__ __forceinline__ void a_ready(const Unit&) const {}
    __device__ __forceinline__ void done(const Unit&) const {}
};

typedef float f32x2c_t __attribute__((ext_vector_type(2))); typedef __bf16 bf16x2c_t __attribute__((ext_vector_type(2)));
__device__ __forceinline__ unsigned cvt_pk_bf16(float lo, float hi) { f32x2c_t v = {lo, hi}; bf16x2c_t b = __builtin_convertvector(v, bf16x2c_t); return __builtin_bit_cast(unsigned, b); }
typedef float f32x2 __attribute__((ext_vector_type(2)));
__device__ __forceinline__ f32x2 gelu_pk(f32x2 v) {
    const f32x2 av = __builtin_elementwise_abs(v), d = av * 0.2316418882f + 1.0f;
    f32x2 t; t.x = __builtin_amdgcn_rcpf(d.x); t.y = __builtin_amdgcn_rcpf(d.y);
    f32x2 q = t * 0.5307027145f + (-0.7265760135f); q = q * t + 0.7107068705f; q = q * t + (-0.142248368f); q = q * t + 0.127414796f; q = q * t;
    const f32x2 s = (v * v) * (-0.72134752044f);
    f32x2 e; e.x = __builtin_amdgcn_exp2f(s.x); e.y = __builtin_amdgcn_exp2f(s.y);
    const f32x2 m = v * (q * e), r = v - m;
    f32x2 o; o.x = v.x < 0.f ? m.x : r.x; o.y = v.y < 0.f ? m.y : r.y; return o;
}

__device__ __forceinline__ unsigned short f2bf1(float f) { unsigned u = __builtin_bit_cast(unsigned, f); return (unsigned short)((u + 0x7fffu + ((u >> 16) & 1u)) >> 16); }
constexpr float RMS_EPS = 1e-6f;
__device__ __forceinline__ float xsum16(float v) { const auto r = __builtin_amdgcn_permlane16_swap(__builtin_bit_cast(unsigned, v), __builtin_bit_cast(unsigned, v), false, false); return __builtin_bit_cast(float, (unsigned)r[0]) + __builtin_bit_cast(float, (unsigned)r[1]); }
__device__ __forceinline__ float xsum32(float v) { const auto r = __builtin_amdgcn_permlane32_swap(__builtin_bit_cast(unsigned, v), __builtin_bit_cast(unsigned, v), false, false); return __builtin_bit_cast(float, (unsigned)r[0]) + __builtin_bit_cast(float, (unsigned)r[1]); }
__device__ __forceinline__ void row_rstd8(const float* rowss, int row0, int fq, float (&rsv)[2][4]) {
    f32x4 pv[2][4];
#pragma unroll
    for (int ai = 0; ai < 2; ++ai)
#pragma unroll
        for (int m = 0; m < 4; ++m) pv[ai][m] = *(const f32x4*)(rowss + (size_t)(row0 + ai * HALF + m * 16) * 16 + 4 * fq);
#pragma unroll
    for (int ai = 0; ai < 2; ++ai)
#pragma unroll
        for (int m = 0; m < 4; ++m) rsv[ai][m] = (pv[ai][m][0] + pv[ai][m][1]) + (pv[ai][m][2] + pv[ai][m][3]);
#pragma unroll
    for (int ai = 0; ai < 2; ++ai)
#pragma unroll
        for (int m = 0; m < 4; ++m) rsv[ai][m] = xsum16(rsv[ai][m]);
#pragma unroll
    for (int ai = 0; ai < 2; ++ai)
#pragma unroll
        for (int m = 0; m < 4; ++m) rsv[ai][m] = xsum32(rsv[ai][m]);
#pragma unroll
    for (int ai = 0; ai < 2; ++ai)
#pragma unroll
        for (int m = 0; m < 4; ++m) rsv[ai][m] = __builtin_amdgcn_rsqf(rsv[ai][m] * (1.0f / 1024.0f) + RMS_EPS);
}
__device__ __forceinline__ float row_rstd(const float* rowss, int row, int fq) {
    const f32x4 pv = *(const f32x4*)(rowss + (size_t)row * 16 + 4 * fq);
    float s = (pv[0] + pv[1]) + (pv[2] + pv[3]);
    s += __shfl_xor(s, 16); s += __shfl_xor(s, 32);
    return __builtin_amdgcn_rsqf(s * (1.0f / 1024.0f) + RMS_EPS);
}
struct EpiSwiglu {
    static constexpr bool PERM = true, AFTER_DRAIN = false;
    bf16_t* O; int ldo; const float* rowss;
    __device__ __forceinline__ void operator()(const f32x4 (&acc)[2][2][4][2], const Unit& u, int wr, int wc, int fr, int fq) const {
        const int row0 = u.pm * BM + wr * 64 + fr, col0 = u.pn * HALF + wc * 32 + 8 * fq;
        float rsv[2][4]; row_rstd8(rowss, row0, fq, rsv);
#pragma unroll
        for (int ai = 0; ai < 2; ++ai)
#pragma unroll
            for (int m = 0; m < 4; ++m) {
                const int row = row0 + ai * HALF + m * 16;
                const float rs = rsv[ai][m];
                float o[8]; const float rs2 = rs * rs, nrs = rs * -1.4426950408889634f;
#pragma unroll
                for (int n = 0; n < 2; ++n) {
                    const f32x4 t = (acc[ai][0][m][n] * acc[ai][1][m][n]) * rs2, ea = acc[ai][0][m][n] * nrs;
#pragma unroll
                    for (int e = 0; e < 4; ++e) o[n * 4 + e] = t[e] * __builtin_amdgcn_rcpf(1.0f + __builtin_amdgcn_exp2f(ea[e]));
                }
                u32x4 w; w.x = cvt_pk_bf16(o[0], o[1]); w.y = cvt_pk_bf16(o[2], o[3]); w.z = cvt_pk_bf16(o[4], o[5]); w.w = cvt_pk_bf16(o[6], o[7]);
                *(u32x4*)(O + (size_t)row * ldo + col0) = w;
            }
    }
};
struct EpiResid {
    static constexpr bool PERM = true, AFTER_DRAIN = false;
    const float* Xin; float* X; bf16_t* XB; float* rowss_next; float scale;
    __device__ __forceinline__ void operator()(const f32x4 (&acc)[2][2][4][2], const Unit& u, int wr, int wc, int fr, int fq) const {
        const int row0 = u.pm * BM + wr * 64 + fr, col0 = u.pn * BM + wc * 32 + 8 * fq;
#pragma unroll
        for (int ai = 0; ai < 2; ++ai)
#pragma unroll
          for (int mh = 0; mh < 2; ++mh) {
            f32x4 xv[2][2][2];
#pragma unroll
            for (int mm = 0; mm < 2; ++mm)
#pragma unroll
                for (int bj = 0; bj < 2; ++bj) {
                    const float* xi = Xin + (size_t)(row0 + ai * HALF + (2 * mh + mm) * 16) * 1024 + col0 + bj * HALF;
                    xv[mm][bj][0] = *(const f32x4*)xi; xv[mm][bj][1] = *(const f32x4*)(xi + 4);
                }
#pragma unroll
            for (int mm = 0; mm < 2; ++mm) {
                const int m = 2 * mh + mm;
                const int row = row0 + ai * HALF + m * 16;
                float ss = 0.f;
#pragma unroll
                for (int bj = 0; bj < 2; ++bj) {
                    float* xp = X + (size_t)row * 1024 + col0 + bj * HALF;
                    const f32x4 x0 = xv[mm][bj][0] + acc[ai][bj][m][0] * scale, x1 = xv[mm][bj][1] + acc[ai][bj][m][1] * scale;
                    *(f32x4*)xp = x0; *(f32x4*)(xp + 4) = x1;
                    ss += (x0[0] * x0[0] + x0[1] * x0[1]) + (x0[2] * x0[2] + x0[3] * x0[3]) + (x1[0] * x1[0] + x1[1] * x1[1]) + (x1[2] * x1[2] + x1[3] * x1[3]);
                    u32x4 w; w.x = cvt_pk_bf16(x0[0], x0[1]); w.y = cvt_pk_bf16(x0[2], x0[3]); w.z = cvt_pk_bf16(x1[0], x1[1]); w.w = cvt_pk_bf16(x1[2], x1[3]);
                    *(u32x4*)(XB + (size_t)row * 1024 + col0 + bj * HALF) = w;
                }
                ss = xsum32(xsum16(ss));
                if (fq == 0) rowss_next[(size_t)row * 16 + u.pn * 4 + wc] = ss;
            }
          }
    }
};
struct EpiWin {
    static constexpr bool PERM = true, AFTER_DRAIN = false;
    bf16_t *Z, *Q, *Kb, *Vt; const float* rowss; float qscale;
    __device__ __forceinline__ void operator()(const f32x4 (&acc)[2][2][4][2], const Unit& u, int wr, int wc, int fr, int fq) const {
        const int row0 = u.pm * BM + wr * 64 + fr, cw = wc * 32 + 8 * fq;
        float rsv[2][4]; row_rstd8(rowss, row0, fq, rsv);
#pragma unroll
        for (int ai = 0; ai < 2; ++ai)
#pragma unroll
            for (int m = 0; m < 4; ++m) {
                const int row = row0 + ai * HALF + m * 16;
                const float rs = rsv[ai][m];
                if (u.pn < 4) {
#pragma unroll
                    for (int bj = 0; bj < 2; ++bj) {
                        const f32x4 v0 = acc[ai][bj][m][0] * rs, v1 = acc[ai][bj][m][1] * rs;
                        const f32x2 a = gelu_pk((f32x2){v0[0], v0[1]}), b = gelu_pk((f32x2){v0[2], v0[3]}), c = gelu_pk((f32x2){v1[0], v1[1]}), d = gelu_pk((f32x2){v1[2], v1[3]});
                        u32x4 w; w.x = cvt_pk_bf16(a.x, a.y); w.y = cvt_pk_bf16(b.x, b.y); w.z = cvt_pk_bf16(c.x, c.y); w.w = cvt_pk_bf16(d.x, d.y);
                        *(u32x4*)(Z + (size_t)row * 1024 + u.pn * BM + bj * HALF + cw) = w;
                    }
                } else if (u.pn < 8) {
                    bf16_t* base = (u.pn < 6) ? Q : Kb; const float sc = (u.pn < 6) ? rs * qscale : rs; const int ct = (u.pn & 1) * BM;
#pragma unroll
                    for (int bj = 0; bj < 2; ++bj) {
                        const f32x4 v0 = acc[ai][bj][m][0] * sc, v1 = acc[ai][bj][m][1] * sc;
                        u32x4 w; w.x = cvt_pk_bf16(v0[0], v0[1]); w.y = cvt_pk_bf16(v0[2], v0[3]); w.z = cvt_pk_bf16(v1[0], v1[1]); w.w = cvt_pk_bf16(v1[2], v1[3]);
                        *(u32x4*)(base + (size_t)row * 512 + ct + bj * HALF + cw) = w;
                    }
                } else {
                    const int b = row >> 11, s = row & 2047;
#pragma unroll
                    for (int bj = 0; bj < 2; ++bj) {
                        const int h = 2 * (u.pn - 8) + bj;
                        bf16_t* vp = Vt + ((size_t)(b * 4 + h) * 128 + cw) * 2048 + s;
#pragma unroll
                        for (int n = 0; n < 2; ++n)
#pragma unroll
                            for (int e = 0; e < 4; ++e) vp[(size_t)(n * 4 + e) * 2048] = f2bf1(acc[ai][bj][m][n][e] * rs);
                    }
                }
            }
    }
};
__device__ __forceinline__ void gemm_pre_b(PG8_LAS unsigned char* lds, const bf16_t* Bt, int M, int N, int K, int G, int c) {
    int tid_ = threadIdx.x; asm volatile("" : "+v"(tid_));
    const int tid = tid_, wid = __builtin_amdgcn_readfirstlane(tid >> 6);
    StaticOrder S; S.init(M, N, G, c); Unit u;
    if (!S.next(0, u)) return;
    unsigned voffB[2];
#pragma unroll
    for (int i = 0; i < 2; ++i) { int R, C; stage_rc(tid * 16 + i * 8192, R, C); const int Rb = (R & ~31) + perm32(R & 31); voffB[i] = (unsigned)(Rb * K + C) * 2u; }
    const size_t hstep = (size_t)HALF * K * 2, tstep = 2 * hstep; const unsigned ldsw = (unsigned)wid * 1024u;
    const char* cB = (const char*)Bt + (size_t)u.pn * tstep;
#pragma unroll
    for (int h = 0; h < 2; ++h)
#pragma unroll
        for (int i = 0; i < 2; ++i)
            __builtin_amdgcn_global_load_lds((const unsigned*)(cB + h * hstep + voffB[i]), (PG8_LAS unsigned*)(lds + (4 + h) * HTB + ldsw + i * 8192), 16, 0, 0);
}
template <class Epi, class Sched, bool ALIGN_EPI = false, bool SP2 = false>
__device__ __forceinline__ void gemm_phase(PG8_LAS unsigned char* lds, const Gemm g, const Sched& S, const Epi& E, bool pre_b = false) {
    int tid_ = threadIdx.x; asm volatile("" : "+v"(tid_));
    const int tid = tid_, wid = __builtin_amdgcn_readfirstlane(tid >> 6), lane = tid & 63, wr = wid >> 2, wc = wid & 3, fr = lane & 15, fq = lane >> 4;
    const int K = g.K, nt = K / BK;
    unsigned voffA[2], voffB[2];
#pragma unroll
    for (int i = 0; i < 2; ++i) { int R, C; stage_rc(tid * 16 + i * 8192, R, C); const int Rb = Epi::PERM ? ((R & ~31) + perm32(R & 31)) : R;
        voffA[i] = (unsigned)(R * K + C) * 2u; voffB[i] = (unsigned)(Rb * K + C) * 2u; }
    const size_t kstep = (size_t)(BK * 2);
    const size_t hstep = (size_t)HALF * K * 2;
    const size_t tstep = 2 * hstep;
    const unsigned ldsw = (unsigned)wid * 1024u;
    const int aoff = lds_byte(wr * 64 + fr, fq * 8), boff = lds_byte(wc * 32 + fr, fq * 8);
#define PG8_SA(b, h) (((b) * 2 + (h)) * HTB)
#define PG8_SB(b, h) ((4 + (b) * 2 + (h)) * HTB)
#define PG8_STAGE(bufoff, gbase, voff) do { _Pragma("unroll") for (int _i = 0; _i < 2; ++_i) \
        __builtin_amdgcn_global_load_lds((const unsigned*)((const char*)(gbase) + (voff)[_i]), (PG8_LAS unsigned*)(lds + (bufoff) + ldsw + _i * 8192), 16, 0, 0); } while (0)
#define PG8_LDA(dst, b, h) do { _Pragma("unroll") for (int m = 0; m < 4; ++m) _Pragma("unroll") for (int k = 0; k < 2; ++k) dst[m][k] = *(const PG8_LAS bf16x8*)(lds + PG8_SA(b, h) + aoff + m * 2048 + k * 1024); } while (0)
#define PG8_LDB(dst, b, h) do { _Pragma("unroll") for (int n = 0; n < 2; ++n) _Pragma("unroll") for (int k = 0; k < 2; ++k) dst[n][k] = *(const PG8_LAS bf16x8*)(lds + PG8_SB(b, h) + boff + n * 2048 + k * 1024); } while (0)
#define PG8_MMA(ai, bj, At, Bt) do { __builtin_amdgcn_s_setprio(1); _Pragma("unroll") for (int m = 0; m < 4; ++m) _Pragma("unroll") for (int n = 0; n < 2; ++n) _Pragma("unroll") for (int k = 0; k < 2; ++k) \
        acc[ai][bj][m][n] = __builtin_amdgcn_mfma_f32_16x16x32_bf16(Bt[n][k], At[m][k], acc[ai][bj][m][n], 0, 0, 0); __builtin_amdgcn_s_setprio(0); } while (0)
#define PG8_WAIT_V(n) asm volatile("s_waitcnt vmcnt(" #n ")" ::: "memory")
#define PG8_WAIT_L(n) asm volatile("s_waitcnt lgkmcnt(" #n ")" ::: "memory")
#define PG8_BAR __builtin_amdgcn_s_barrier()
#define PG8_SCHED __builtin_amdgcn_sched_barrier(0)
    Unit cur, nxt; int ui = 0;
    if (!S.next(0, cur)) return;
    f32x4 acc[2][2][4][2];
#pragma unroll
    for (int a = 0; a < 2; ++a)
#pragma unroll
        for (int b = 0; b < 2; ++b)
#pragma unroll
            for (int m = 0; m < 4; ++m)
#pragma unroll
                for (int n = 0; n < 2; ++n) acc[a][b][m][n] = (f32x4){0.f, 0.f, 0.f, 0.f};
    bf16x8 At[4][2], B0[2][2], B1[2][2];
    const char* cA = (const char*)g.A + (size_t)cur.pm * tstep; const char* cB = (const char*)g.Bt + (size_t)cur.pn * tstep;
    S.a_ready(cur);
    if constexpr (SP2) {
        if (!pre_b) { PG8_STAGE(PG8_SB(0, 0), cB, voffB); PG8_STAGE(PG8_SB(0, 1), cB + hstep, voffB); }
        PG8_STAGE(PG8_SA(0, 0), cA, voffA); PG8_STAGE(PG8_SA(0, 1), cA + hstep, voffA);
        if (wr == 1) PG8_BAR;
        PG8_WAIT_V(2); PG8_BAR;
        PG8_STAGE(PG8_SB(1, 0), cB + kstep, voffB); PG8_STAGE(PG8_SA(1, 0), cA + kstep, voffA); PG8_STAGE(PG8_SB(1, 1), cB + hstep + kstep, voffB);
        PG8_WAIT_V(6); PG8_BAR;
    } else {
        PG8_STAGE(PG8_SB(0, 0), cB, voffB); PG8_STAGE(PG8_SA(0, 0), cA, voffA); PG8_STAGE(PG8_SB(0, 1), cB + hstep, voffB); PG8_STAGE(PG8_SA(0, 1), cA + hstep, voffA);
        if (wr == 1) PG8_BAR;
        PG8_WAIT_V(4); PG8_BAR;
        PG8_STAGE(PG8_SB(1, 0), cB + kstep, voffB); PG8_STAGE(PG8_SA(1, 0), cA + kstep, voffA); PG8_STAGE(PG8_SB(1, 1), cB + hstep + kstep, voffB);
        PG8_WAIT_V(6); PG8_BAR;
    }
    for (;;) {
        const bool has_next = S.next(ui + 1, nxt);
        const char* nA = has_next ? (const char*)g.A + (size_t)nxt.pm * tstep : cA; const char* nB = has_next ? (const char*)g.Bt + (size_t)nxt.pn * tstep : cB;
        for (int t = 0; t < nt; t += 2) {
            const bool last = (t == nt - 2);
            const char* a1 = cA + (size_t)(t + 1) * kstep;
            const char* a2 = last ? nA : cA + (size_t)(t + 2) * kstep; const char* b2 = last ? nB : cB + (size_t)(t + 2) * kstep;
            const char* a3 = a2 + kstep; const char* b3 = b2 + kstep;
            if (last && has_next) S.a_ready(nxt);
            if constexpr (SP2) {
            PG8_LDB(B0, 0, 0); PG8_LDB(B1, 0, 1); PG8_SCHED; PG8_LDA(At, 0, 0); PG8_STAGE(PG8_SA(1, 1), a1 + hstep, voffA);
            PG8_WAIT_V(8); PG8_WAIT_L(0); PG8_BAR; PG8_MMA(0, 0, At, B0); PG8_MMA(0, 1, At, B1); PG8_BAR; PG8_SCHED;
            PG8_LDA(At, 0, 1); PG8_STAGE(PG8_SB(0, 0), b2, voffB); PG8_STAGE(PG8_SB(0, 1), b2 + hstep, voffB); PG8_STAGE(PG8_SA(0, 0), a2, voffA);
            PG8_WAIT_V(8); PG8_WAIT_L(0); PG8_BAR; PG8_MMA(1, 0, At, B0); PG8_MMA(1, 1, At, B1); PG8_BAR; PG8_SCHED;
            PG8_LDB(B0, 1, 0); PG8_LDB(B1, 1, 1); PG8_SCHED; PG8_LDA(At, 1, 0); PG8_STAGE(PG8_SA(0, 1), a2 + hstep, voffA);
            PG8_WAIT_V(8); PG8_WAIT_L(0); PG8_BAR; PG8_MMA(0, 0, At, B0); PG8_MMA(0, 1, At, B1); PG8_BAR; PG8_SCHED;
            PG8_LDA(At, 1, 1); PG8_STAGE(PG8_SB(1, 0), b3, voffB); PG8_STAGE(PG8_SB(1, 1), b3 + hstep, voffB); PG8_STAGE(PG8_SA(1, 0), a3, voffA);
            PG8_WAIT_V(8); PG8_WAIT_L(0); PG8_BAR; PG8_MMA(1, 0, At, B0); PG8_MMA(1, 1, At, B1); PG8_BAR; PG8_SCHED;
            } else {
            PG8_LDB(B0, 0, 0); PG8_SCHED; PG8_LDA(At, 0, 0); PG8_STAGE(PG8_SA(1, 1), a1 + hstep, voffA);
            PG8_WAIT_L(8); PG8_BAR; PG8_WAIT_L(0); PG8_MMA(0, 0, At, B0); PG8_BAR; PG8_SCHED;
            PG8_LDB(B1, 0, 1); PG8_STAGE(PG8_SB(0, 0), b2, voffB);
            PG8_BAR; PG8_WAIT_L(0); PG8_MMA(0, 1, At, B1); PG8_BAR;
            PG8_LDA(At, 0, 1); PG8_STAGE(PG8_SA(0, 0), a2, voffA);
            PG8_BAR; PG8_WAIT_L(0); PG8_MMA(1, 0, At, B0); PG8_BAR; PG8_SCHED;
            PG8_STAGE(PG8_SB(0, 1), b2 + hstep, voffB);
            PG8_WAIT_V(6); PG8_BAR; PG8_MMA(1, 1, At, B1); PG8_BAR;
            PG8_LDB(B0, 1, 0); PG8_SCHED; PG8_LDA(At, 1, 0); PG8_STAGE(PG8_SA(0, 1), a2 + hstep, voffA);
            PG8_WAIT_L(8); PG8_BAR; PG8_WAIT_L(0); PG8_MMA(0, 0, At, B0); PG8_BAR; PG8_SCHED;
            PG8_LDB(B1, 1, 1); PG8_STAGE(PG8_SB(1, 0), b3, voffB);
            PG8_BAR; PG8_WAIT_L(0); PG8_MMA(0, 1, At, B1); PG8_BAR;
            PG8_LDA(At, 1, 1); PG8_STAGE(PG8_SA(1, 0), a3, voffA);
            PG8_BAR; PG8_WAIT_L(0); PG8_MMA(1, 0, At, B0); PG8_BAR; PG8_SCHED;
            PG8_STAGE(PG8_SB(1, 1), b3 + hstep, voffB);
            PG8_WAIT_V(6); PG8_BAR; PG8_MMA(1, 1, At, B1); PG8_BAR;
            }
        }
        if constexpr (ALIGN_EPI) { if (wr == 0) PG8_BAR; }
        if constexpr (!Epi::AFTER_DRAIN) { E(acc, cur, wr, wc, fr, fq); S.done(cur); }
        if (!has_next) break;
#pragma unroll
        for (int a = 0; a < 2; ++a)
#pragma unroll
            for (int b = 0; b < 2; ++b)
#pragma unroll
                for (int m = 0; m < 4; ++m)
#pragma unroll
                    for (int n = 0; n < 2; ++n) acc[a][b][m][n] = (f32x4){0.f, 0.f, 0.f, 0.f};
        cur = nxt; cA = nA; cB = nB; ++ui;
        if constexpr (ALIGN_EPI) { if (wr == 1) PG8_BAR; }
    }
    PG8_WAIT_V(0);
    if constexpr (!ALIGN_EPI) { if (wr == 0) PG8_BAR; }
    PG8_BAR;
    if constexpr (Epi::AFTER_DRAIN) { E.fused(acc, cur, wr, wc, fr, fq, lds, wid, lane); S.done(cur); }
#undef PG8_SA
#undef PG8_SB
#undef PG8_STAGE
#undef PG8_LDA
#undef PG8_LDB
#undef PG8_MMA
#undef PG8_WAIT_V
#undef PG8_WAIT_L
#undef PG8_BAR
#undef PG8_SCHED
}
}

#ifndef PROBE_MIX_REPS
#define PROBE_MIX_REPS 1
#endif
#ifndef PROBE_G1_REPS
#define PROBE_G1_REPS 1
#endif
#ifndef PROBE_G3_REPS
#define PROBE_G3_REPS 1
#endif
#ifndef PROBE_PRO_REPS
#define PROBE_PRO_REPS 1
#endif
#ifndef PROBE_BAR_REPS
#define PROBE_BAR_REPS 1
#endif
#ifndef PROBE_SGU_REPS
#define PROBE_SGU_REPS 1
#endif
#ifndef PROBE_ATT_REPS
#define PROBE_ATT_REPS 1
#endif
#define LAS __attribute__((address_space(3)))
using pg8::bf16_t; using pg8::bf16x8; using pg8::f32x4; using pg8::u32x4;
typedef float f32x16 __attribute__((ext_vector_type(16)));
typedef unsigned u32x2 __attribute__((ext_vector_type(2)));
constexpr int DM = 1024, NB = 8, SEQ = 2048, DEPTH = 4, M = NB * SEQ, DFF = 2816, NIN = 2560;
constexpr int NWAVES = 8, NTHREADS = 512;
constexpr int LDS_BYTES = 147456;
constexpr size_t SZ_WGU = (size_t)2 * DFF * DM * 2, SZ_WD = (size_t)DM * DFF * 2, SZ_WIN = (size_t)NIN * DM * 2, SZ_WOUT = (size_t)DM * DM * 2, SZ_SGUW = (size_t)8 * 128 * 128 * 2;
constexpr size_t LO_WGU1 = 0, LO_WD1 = LO_WGU1 + SZ_WGU, LO_WIN = LO_WD1 + SZ_WD, LO_WOUT = LO_WIN + SZ_WIN, LO_WGU2 = LO_WOUT + SZ_WOUT, LO_WD2 = LO_WGU2 + SZ_WGU, LO_SGUW = LO_WD2 + SZ_WD, L_STRIDE = LO_SGUW + SZ_SGUW;
constexpr size_t WS_W = 0, WS_X = WS_W + DEPTH * L_STRIDE, WS_XB = WS_X + (size_t)M * DM * 4, WS_RS = WS_XB + (size_t)M * DM * 2, WS_OV = WS_RS + (size_t)2 * M * 16 * 4;
constexpr size_t WS_ACT = WS_OV;
constexpr size_t WS_Z = WS_OV, WS_Q = WS_Z + (size_t)M * 1024 * 2, WS_K = WS_Q + (size_t)M * 512 * 2, WS_VT = WS_K + (size_t)M * 512 * 2, WS_Y = WS_VT + (size_t)M * 512 * 2;
constexpr size_t WS_CTL = WS_Y + (size_t)M * 1024 * 2, CTL_BYTES = 65536;
constexpr size_t WS_END = WS_CTL + CTL_BYTES;
static_assert(WS_ACT + (size_t)M * DFF * 2 <= WS_CTL, "overlay");
static_assert(L_STRIDE % 256 == 0 && WS_X % 256 == 0 && WS_OV % 256 == 0, "alignment");

__device__ __forceinline__ unsigned f2bf(float f) { unsigned u = __builtin_bit_cast(unsigned, f); return (u + 0x7fffu + ((u >> 16) & 1u)) >> 16; }
__device__ __forceinline__ unsigned pk2(float lo, float hi) { return f2bf(lo) | (f2bf(hi) << 16); }
typedef float f32x2_t __attribute__((ext_vector_type(2))); typedef __bf16 bf16x2_t __attribute__((ext_vector_type(2)));
__device__ __forceinline__ unsigned cvtpk(float lo, float hi) { f32x2_t v = {lo, hi}; bf16x2_t b = __builtin_convertvector(v, bf16x2_t); return __builtin_bit_cast(unsigned, b); }
__device__ __forceinline__ float bflo(unsigned w) { return __builtin_bit_cast(float, w << 16); }
__device__ __forceinline__ float bfhi(unsigned w) { return __builtin_bit_cast(float, w & 0xffff0000u); }
__device__ __forceinline__ float wave_sum(float v) {
#pragma unroll
    for (int o = 1; o < 64; o <<= 1) v += __shfl_xor(v, o);
    return v;
}
#define WG_BAR() do { asm volatile("s_waitcnt vmcnt(0) lgkmcnt(0)" ::: "memory"); __builtin_amdgcn_s_barrier(); asm volatile("" ::: "memory"); } while (0)

#define XB_TMO      128
#define XB_XCNT(j)  (256  + 64 * (j))
#define XB_XSUB(j)  (1280 + 64 * (j))
#define XB_XGEN(j)  (2304 + 64 * (j))
#define XB_TOP      3328
#define XB_TOPGEN   3392
#define XCD_BAR_WORDS 3456
#define XB_SPIN_CAP (1u << 22)

__device__ __forceinline__ unsigned xb_ld(unsigned* p)              { return __hip_atomic_load(p, __ATOMIC_RELAXED, __HIP_MEMORY_SCOPE_AGENT); }
__device__ __forceinline__ unsigned xb_add(unsigned* p, unsigned v) { return __hip_atomic_fetch_add(p, v, __ATOMIC_RELAXED, __HIP_MEMORY_SCOPE_AGENT); }
__device__ __forceinline__ unsigned xb_xcc_id() { return (unsigned)__builtin_amdgcn_s_getreg((3 << 11) | 20) & 0xFu; }
#define XB_SPIN(cond, bar) do { unsigned _sp = 0; while (cond) { __builtin_amdgcn_s_sleep(1); \
    if ((++_sp & 255u) == 0u) { if (xb_ld(&(bar)[XB_TMO])) break; if (_sp > XB_SPIN_CAP) { atomicAdd(&(bar)[XB_TMO], 1u); break; } } } } while (0)

struct XcdBarrier {
    unsigned* bar; unsigned x;
    volatile LAS unsigned* st;
};

__device__ __forceinline__ XcdBarrier xcd_barrier_post(unsigned* bar, volatile LAS unsigned* st) {
    XcdBarrier b; b.bar = bar; b.x = xb_xcc_id(); b.st = st;
    if (threadIdx.x == 0) (void)xb_add(&bar[XB_XCNT(b.x)], 1u);
    return b;
}
__device__ __forceinline__ void xcd_barrier_complete(unsigned* bar, unsigned x, unsigned& nloc, unsigned& nx) {
    const unsigned G = gridDim.x * gridDim.y * gridDim.z;
    unsigned sum, cnt, mine, sp = 0u;
    for (;;) {
        sum = 0u; cnt = 0u; mine = 0u;
#pragma unroll
        for (unsigned j = 0; j < 16; ++j) { const unsigned c = xb_ld(&bar[XB_XCNT(j)]); sum += c; cnt += (c > 0u) ? 1u : 0u; mine = (j == x) ? c : mine; }
        if (sum == G) break;
        __builtin_amdgcn_s_sleep(1);
        if ((++sp & 255u) == 0u) { if (xb_ld(&bar[XB_TMO])) break; if (sp > XB_SPIN_CAP) { atomicAdd(&bar[XB_TMO], 1u); break; } }
    }
    nloc = mine > 0u ? mine : 1u; nx = cnt > 0u ? cnt : 1u;
}

__device__ __forceinline__ void xcd_barrier(const XcdBarrier& b) {
    asm volatile("s_waitcnt vmcnt(0)" ::: "memory");
    __syncthreads();
    if (threadIdx.x == 0) {
        unsigned* bar = b.bar;
        __builtin_amdgcn_s_waitcnt(0);
        unsigned nloc = b.st[0], nx = b.st[1];
        if (nloc == 0u) { xcd_barrier_complete(bar, b.x, nloc, nx); b.st[0] = nloc; b.st[1] = nx; }
        const unsigned old = xb_add(&bar[XB_XSUB(b.x)], 1u);
        const unsigned gen = old / nloc;
        if (old + 1u == (gen + 1u) * nloc) {
            __builtin_amdgcn_fence(__ATOMIC_RELEASE, "agent");
            asm volatile("s_waitcnt vmcnt(0)" ::: "memory");
            const unsigned og = xb_add(&bar[XB_TOP], 1u);
            const unsigned tg = og / nx;
            if (og + 1u == (tg + 1u) * nx) xb_add(&bar[XB_TOPGEN], 1u);
            else XB_SPIN(xb_ld(&bar[XB_TOPGEN]) == tg, bar);
            __builtin_amdgcn_fence(__ATOMIC_ACQUIRE, "agent");
            xb_add(&bar[XB_XGEN(b.x)], 1u);
            asm volatile("s_waitcnt vmcnt(0)" ::: "memory");
        } else {
            XB_SPIN(xb_ld(&bar[XB_XGEN(b.x)]) == gen, bar);
            __builtin_amdgcn_fence(__ATOMIC_ACQUIRE, "agent");
            asm volatile("s_waitcnt vmcnt(0)" ::: "memory");
        }
    }
    __syncthreads();
}

constexpr int TR_SCR = 64 * 65 * 4;
__device__ __forceinline__ void tr_item(const float* W, int K, int N, const float* gain, bf16_t* WT, int mode, LAS float* scr, int item, int lane) {
    const int nblk = N / 64, kb = item / nblk, nb = item % nblk, k0 = 64 * kb, n0 = 64 * nb;
    const int lr = lane >> 4, n4 = 4 * (lane & 15);
    f32x4 v[16]; float gk[16];
    const float* src = W + (size_t)(k0 + lr) * N + n0 + n4;
    if (gain) {
#pragma unroll
        for (int i = 0; i < 16; ++i) gk[i] = gain[k0 + 4 * i + lr];
    } else {
#pragma unroll
        for (int i = 0; i < 16; ++i) gk[i] = 1.0f;
    }
#pragma unroll
    for (int i = 0; i < 16; ++i) v[i] = *(const f32x4*)(src + (size_t)(4 * i) * N);
#pragma unroll
    for (int i = 0; i < 16; ++i) v[i] = v[i] * gk[i];
#pragma unroll
    for (int i = 0; i < 16; ++i) { LAS float* d = scr + (4 * i + lr) * 65 + n4; d[0] = v[i][0]; d[1] = v[i][1]; d[2] = v[i][2]; d[3] = v[i][3]; }
    asm volatile("s_waitcnt lgkmcnt(0)" ::: "memory");
    const int c = lane & 7;
#pragma unroll
    for (int j = 0; j < 8; ++j) { const int n = (lane >> 3) + 8 * j; const LAS float* s = scr + (8 * c) * 65 + n;
        u32x4 o; o.x = pk2(s[0 * 65], s[1 * 65]); o.y = pk2(s[2 * 65], s[3 * 65]); o.z = pk2(s[4 * 65], s[5 * 65]); o.w = pk2(s[6 * 65], s[7 * 65]);
        const int nn = n0 + n; const int dr = (mode == 0) ? nn : (256 * (nn >> 7) + (nn & 127) + (mode == 2 ? 128 : 0));
        *(u32x4*)(WT + (size_t)dr * K + k0 + 8 * c) = o; }
    asm volatile("s_waitcnt lgkmcnt(0)" ::: "memory");
}

struct Args { const float* in[21]; float* out; unsigned char* ws; };
enum { I_X = 0, I_F1N, I_F1G, I_F1U, I_F1D, I_MIXN, I_WIN, I_SGUN, I_SGUW, I_SGUB, I_LQ1, I_LK1, I_LQ2, I_LK2, I_SUBLN, I_WOUT, I_F2N, I_F2G, I_F2U, I_F2D, I_FINN };

constexpr int IT_GU = (DM / 64) * (DFF / 64), IT_D = (DFF / 64) * (DM / 64), IT_IN = (DM / 64) * (NIN / 64), IT_OUT = (DM / 64) * (DM / 64);
constexpr int IT_FFN = 2 * IT_GU + IT_D, IT_LAYER = 2 * IT_FFN + IT_IN + IT_OUT;
__device__ __forceinline__ void convert_items(const Args& a, LAS unsigned char* lds, int l, int it0, int it1, int w, int nw, int wave, int lane) {
    LAS float* scr = (LAS float*)(lds + wave * TR_SCR);
    unsigned char* wl = a.ws + WS_W + (size_t)l * L_STRIDE;
    for (int it = it0 + w; it < it1; it += nw) {
        int r = it;
        if (r < 2 * IT_FFN) {
            const int f = r / IT_FFN; r -= f * IT_FFN;
            const float* gn = a.in[f ? I_F2N : I_F1N] + (size_t)l * DM;
            bf16_t* wgu = (bf16_t*)(wl + (f ? LO_WGU2 : LO_WGU1)); bf16_t* wd = (bf16_t*)(wl + (f ? LO_WD2 : LO_WD1));
            if (r < IT_GU) tr_item(a.in[f ? I_F2G : I_F1G] + (size_t)l * DM * DFF, DM, DFF, gn, wgu, 1, scr, r, lane);
            else if (r < 2 * IT_GU) tr_item(a.in[f ? I_F2U : I_F1U] + (size_t)l * DM * DFF, DM, DFF, gn, wgu, 2, scr, r - IT_GU, lane);
            else tr_item(a.in[f ? I_F2D : I_F1D] + (size_t)l * DFF * DM, DFF, DM, nullptr, wd, 0, scr, r - 2 * IT_GU, lane);
        } else {
            r -= 2 * IT_FFN;
            if (r < IT_IN) tr_item(a.in[I_WIN] + (size_t)l * DM * NIN, DM, NIN, a.in[I_MIXN] + (size_t)l * DM, (bf16_t*)(wl + LO_WIN), 0, scr, r, lane);
            else tr_item(a.in[I_WOUT] + (size_t)l * DM * DM, DM, DM, nullptr, (bf16_t*)(wl + LO_WOUT), 0, scr, r - IT_IN, lane);
        }
    }
}
__device__ __forceinline__ bool slot_range(int l, int slot, int& layer, int& s0, int& s1) {
    if (l == 0) { if (slot == 0) { layer = 0; s0 = 2 * IT_GU; s1 = IT_LAYER; } else { layer = 1; s0 = (slot - 1) * (IT_LAYER / 2); s1 = slot * (IT_LAYER / 2); } return true; }
    if (l + 1 >= DEPTH) return false;
    layer = l + 1; s0 = (IT_LAYER * slot) / 3; s1 = (IT_LAYER * (slot + 1)) / 3; return true;
}
__device__ __forceinline__ void prologue(const Args& a, LAS unsigned char* lds, int vcu, int G, int wave, int lane) {
    const int gw = vcu * NWAVES + wave, NGW = G * NWAVES;
    if (G == 256) convert_items(a, lds, 0, 0, 2 * IT_GU, gw, NGW, wave, lane);
    else for (int l = 0; l < DEPTH; ++l) convert_items(a, lds, l, 0, IT_LAYER, gw, NGW, wave, lane);
    {
        const int gt = vcu * NTHREADS + wave * 64 + lane, NT = G * NTHREADS;
        for (int i = gt; i < DEPTH * 8 * 128 * 128 / 4; i += NT) {
            const int e0 = i * 4, l = e0 >> 17, rem = e0 & 131071, t = (rem >> 7) & 127, s0 = rem & 127;
            const f32x4 w = *(const f32x4*)(a.in[I_SGUW] + e0);
            u32x2 o; o.x = pk2(s0 + 0 <= t ? w[0] : 0.f, s0 + 1 <= t ? w[1] : 0.f); o.y = pk2(s0 + 2 <= t ? w[2] : 0.f, s0 + 3 <= t ? w[3] : 0.f);
            *(u32x2*)((bf16_t*)(a.ws + WS_W + (size_t)l * L_STRIDE + LO_SGUW) + rem) = o;
        }
    }
    {
        const float* x = a.in[I_X]; bf16_t* XB = (bf16_t*)(a.ws + WS_XB); float* rs = (float*)(a.ws + WS_RS);
        for (int m0 = 2 * gw; m0 < M; m0 += 2 * NGW) {
            f32x4 v[2][4];
#pragma unroll
            for (int q = 0; q < 2; ++q)
#pragma unroll
                for (int j = 0; j < 4; ++j) v[q][j] = ((const f32x4*)(x + (size_t)(m0 + q) * DM) + lane)[64 * j];
#pragma unroll
            for (int q = 0; q < 2; ++q) {
                const int m = m0 + q; float s = 0.f;
#pragma unroll
                for (int j = 0; j < 4; ++j) s += (v[q][j][0] * v[q][j][0] + v[q][j][1] * v[q][j][1]) + (v[q][j][2] * v[q][j][2] + v[q][j][3] * v[q][j][3]);
                s = wave_sum(s);
                u32x2* bo = (u32x2*)(XB + (size_t)m * DM) + lane;
#pragma unroll
                for (int j = 0; j < 4; ++j) { u32x2 o; o.x = pk2(v[q][j][0], v[q][j][1]); o.y = pk2(v[q][j][2], v[q][j][3]); bo[64 * j] = o; }
                if (lane < 16) rs[(size_t)m * 16 + lane] = (lane == 0) ? s : 0.f;
            }
        }
    }
}

__device__ __forceinline__ void sgu_unit(LAS unsigned char* lds, const bf16_t* Z, const bf16_t* Wb, const float* ngain, const float* bias, bf16_t* Y, int b, int c, int g) {
    int tid_ = threadIdx.x; asm volatile("" : "+v"(tid_));
    const int tid = tid_, lane = tid & 63, wid = __builtin_amdgcn_readfirstlane(tid >> 6), r32 = lane & 31, hi = lane >> 5;
    const size_t rowbase = (size_t)b * SEQ + (size_t)c * 128;
    bf16x8 wf[8]; u32x2 uu[4]; float bs;
    {
        const int dc_ = wid & 1, tc_ = wid >> 1, t_ = 32 * tc_ + r32;
        const bf16_t* bp_ = Wb + (size_t)t_ * 128 + 8 * hi;
#pragma unroll
        for (int kk = 0; kk < 8; ++kk) wf[kk] = *(const bf16x8*)(bp_ + 16 * kk);
        const bf16_t* up_ = Z + (rowbase + t_) * 1024 + g * 64 + 32 * dc_ + 4 * hi;
#pragma unroll
        for (int j = 0; j < 4; ++j) uu[j] = *(const u32x2*)(up_ + 8 * j);
        bs = bias[t_];
    }
    const f32x4 ng0 = *(const f32x4*)(ngain + (tid & 7) * 8), ng1 = *(const f32x4*)(ngain + (tid & 7) * 8 + 4);
#pragma unroll
    for (int i = 0; i < 2; ++i) {
        const int cid = tid + 512 * i, s = cid >> 3, ch = cid & 7;
        const u32x4 raw = *(const u32x4*)(Z + (rowbase + s) * 1024 + 512 + g * 64 + ch * 8);
        float v[8]; v[0] = bflo(raw.x); v[1] = bfhi(raw.x); v[2] = bflo(raw.y); v[3] = bfhi(raw.y); v[4] = bflo(raw.z); v[5] = bfhi(raw.z); v[6] = bflo(raw.w); v[7] = bfhi(raw.w);
        float ss = 0.f;
#pragma unroll
        for (int e = 0; e < 8; ++e) ss += v[e] * v[e];
        ss += __builtin_bit_cast(float, __builtin_amdgcn_update_dpp(0, __builtin_bit_cast(int, ss), 0xB1, 0xF, 0xF, false));
        ss += __builtin_bit_cast(float, __builtin_amdgcn_update_dpp(0, __builtin_bit_cast(int, ss), 0x4E, 0xF, 0xF, false));
        ss += __builtin_bit_cast(float, __builtin_amdgcn_update_dpp(0, __builtin_bit_cast(int, ss), 0x141, 0xF, 0xF, false));
        const float rstd = __builtin_amdgcn_rsqf(ss * (1.0f / 64.0f) + 1e-6f);
        const float gg[8] = {ng0[0], ng0[1], ng0[2], ng0[3], ng1[0], ng1[1], ng1[2], ng1[3]};
        const int pc = ((s >> 3) ^ ch) * 16 + (s & 7) * 2;
#pragma unroll
        for (int e = 0; e < 8; ++e) *(LAS unsigned short*)(lds + (ch * 8 + e) * 272 + pc) = (unsigned short)f2bf(v[e] * rstd * gg[e]);
    }
    WG_BAR();
    const int dc = wid & 1, tc = wid >> 1;
    f32x16 acc;
#pragma unroll
    for (int r = 0; r < 16; ++r) acc[r] = 0.f;
    const int d = 32 * dc + r32, t = 32 * tc + r32;
    const LAS unsigned char* ap = lds + d * 272; const int dsw = (d >> 3) & 7;
    const bf16_t* bp = Wb + (size_t)t * 128 + 8 * hi;
    bf16x8 af[8];
#pragma unroll
    for (int kk = 0; kk < 8; ++kk) af[kk] = *(const LAS bf16x8*)(ap + (((2 * kk + hi) ^ dsw) * 16));
#pragma unroll
    for (int kk = 0; kk < 8; ++kk) {
        if (kk < 2 * tc + 2) acc = __builtin_amdgcn_mfma_f32_32x32x16_bf16(af[kk], wf[kk], acc, 0, 0, 0);
    }
    bf16_t* yp = Y + (rowbase + t) * 1024 + g * 64 + 32 * dc + 4 * hi;
#pragma unroll
    for (int j = 0; j < 4; ++j) {
        u32x2 o; o.x = cvtpk(bflo(uu[j].x) * (acc[4 * j + 0] + bs), bfhi(uu[j].x) * (acc[4 * j + 1] + bs)); o.y = cvtpk(bflo(uu[j].y) * (acc[4 * j + 2] + bs), bfhi(uu[j].y) * (acc[4 * j + 3] + bs));
        *(u32x2*)(yp + 8 * j) = o;
    }
    WG_BAR();
}

namespace att {
constexpr float ATT_THR = 8.0f;
constexpr int KSTR = 144, K_BYTES = 64 * KSTR, V_BYTES = 128 * KSTR, STAGE = 2 * K_BYTES + V_BYTES, NSTG = 3, COMB_OFF = 0;
static_assert(NSTG * STAGE <= LDS_BYTES - 64 && COMB_OFF + 65536 <= NSTG * STAGE, "attention LDS");
}
__device__ __forceinline__ void attn_scores(const LAS unsigned char* sb, int kt, int qabs, int map, int pir, int hi, float cb, float mref, const bf16x8 (&qf)[4], f32x16& p0, f32x16& p1) {
    using namespace att;
    const LAS unsigned char* kp = sb + map * K_BYTES + pir * KSTR + hi * 16;
    const float lb0 = cb * (float)(64 * kt + 8 * hi - qabs) - mref, lb1 = lb0 + cb * 32.0f;
#pragma unroll
    for (int r = 0; r < 16; ++r) { const float kc = (float)(16 * (r >> 3) + (r & 7)); p0[r] = __builtin_fmaf(cb, kc, lb0); p1[r] = __builtin_fmaf(cb, kc, lb1); }
#pragma unroll
    for (int hb = 0; hb < 2; ++hb) {
        bf16x8 kf[4];
#pragma unroll
        for (int d = 0; d < 2; ++d) { kf[2 * d] = *(const LAS bf16x8*)(kp + (2 * hb + d) * 32); kf[2 * d + 1] = *(const LAS bf16x8*)(kp + 32 * KSTR + (2 * hb + d) * 32); }
        __builtin_amdgcn_sched_barrier(0);
        __builtin_amdgcn_s_setprio(1);
#pragma unroll
        for (int d = 0; d < 2; ++d) {
            p0 = __builtin_amdgcn_mfma_f32_32x32x16_bf16(kf[2 * d], qf[2 * hb + d], p0, 0, 0, 0);
            p1 = __builtin_amdgcn_mfma_f32_32x32x16_bf16(kf[2 * d + 1], qf[2 * hb + d], p1, 0, 0, 0);
        }
        __builtin_amdgcn_s_setprio(0);
        __builtin_amdgcn_sched_barrier(0);
    }
}
__device__ __forceinline__ void attn_softmax(int kt, int qb, int qabs, int hi, f32x16& p0, f32x16& p1, f32x16 (&o)[4], float& mref, float& lrun, bool& mset, bf16x8 (&pf)[4]) {
    using namespace att;
    if (kt >= 2 * qb) {
        const int kbase = 64 * kt + 8 * hi;
#pragma unroll
        for (int r = 0; r < 16; ++r) { const int key = kbase + 16 * (r >> 3) + (r & 7); if (key > qabs) p0[r] = -1e30f; if (key + 32 > qabs) p1[r] = -1e30f; }
    }
    asm volatile("s_nop 15\n\ts_nop 7" : "+v"(p0), "+v"(p1));
    float mx, mx2;
    asm("v_max3_f32 %0, %1, %2, %3" : "=v"(mx) : "v"(p0[0]), "v"(p1[0]), "v"(p0[1]));
    asm("v_max3_f32 %0, %1, %2, %3" : "=v"(mx2) : "v"(p1[1]), "v"(p0[2]), "v"(p1[2]));
#pragma unroll
    for (int r = 3; r < 15; r += 2) {
        asm("v_max3_f32 %0, %1, %2, %3" : "=v"(mx) : "v"(mx), "v"(p0[r]), "v"(p1[r]));
        asm("v_max3_f32 %0, %1, %2, %3" : "=v"(mx2) : "v"(mx2), "v"(p0[r + 1]), "v"(p1[r + 1]));
    }
    asm("v_max3_f32 %0, %1, %2, %3" : "=v"(mx) : "v"(mx), "v"(p0[15]), "v"(p1[15]));
    asm("v_max3_f32 %0, %1, %2, %3" : "=v"(mx) : "v"(mx), "v"(mx2), "v"(mx2));
    { const auto rr = __builtin_amdgcn_permlane32_swap(__builtin_bit_cast(unsigned, mx), __builtin_bit_cast(unsigned, mx), false, false);
      const float ma = __builtin_bit_cast(float, (unsigned)rr[0]), mb = __builtin_bit_cast(float, (unsigned)rr[1]); asm("v_max3_f32 %0, %1, %2, %3" : "=v"(mx) : "v"(ma), "v"(mb), "v"(mb)); }
    const bool need = mset ? (mx > ATT_THR) : (mx > -1e29f);
    if (__any(need)) {
        const float delta = need ? mx : 0.f, f = (need && mset) ? __builtin_amdgcn_exp2f(-delta) : 1.0f;
        mref += delta; mset = mset || need; lrun *= f;
#pragma unroll
        for (int r = 0; r < 16; ++r) { p0[r] -= delta; p1[r] -= delta; }
#pragma unroll
        for (int c = 0; c < 4; ++c)
#pragma unroll
            for (int r = 0; r < 16; ++r) o[c][r] *= f;
    }
    float ps = 0.f;
#pragma unroll
    for (int r = 0; r < 16; ++r) { p0[r] = __builtin_amdgcn_exp2f(p0[r]); p1[r] = __builtin_amdgcn_exp2f(p1[r]); ps += p0[r] + p1[r]; }
    lrun += ps;
    u32x4 w;
    w.x = cvtpk(p0[0], p0[1]); w.y = cvtpk(p0[2], p0[3]); w.z = cvtpk(p0[4], p0[5]); w.w = cvtpk(p0[6], p0[7]); pf[0] = __builtin_bit_cast(bf16x8, w);
    w.x = cvtpk(p0[8], p0[9]); w.y = cvtpk(p0[10], p0[11]); w.z = cvtpk(p0[12], p0[13]); w.w = cvtpk(p0[14], p0[15]); pf[1] = __builtin_bit_cast(bf16x8, w);
    w.x = cvtpk(p1[0], p1[1]); w.y = cvtpk(p1[2], p1[3]); w.z = cvtpk(p1[4], p1[5]); w.w = cvtpk(p1[6], p1[7]); pf[2] = __builtin_bit_cast(bf16x8, w);
    w.x = cvtpk(p1[8], p1[9]); w.y = cvtpk(p1[10], p1[11]); w.z = cvtpk(p1[12], p1[13]); w.w = cvtpk(p1[14], p1[15]); pf[3] = __builtin_bit_cast(bf16x8, w);
}
__device__ __forceinline__ void attn_pv(const LAS unsigned char* sb, int r32, int hi, const bf16x8 (&pf)[4], f32x16 (&o)[4]) {
    using namespace att;
    const LAS unsigned char* vp = sb + 2 * K_BYTES + r32 * KSTR + hi * 16;
#pragma unroll
    for (int kq = 0; kq < 4; ++kq) {
        bf16x8 vf[4];
#pragma unroll
        for (int c = 0; c < 4; ++c) vf[c] = *(const LAS bf16x8*)(vp + c * 32 * KSTR + kq * 32);
        __builtin_amdgcn_sched_barrier(0);
        __builtin_amdgcn_s_setprio(1);
#pragma unroll
        for (int c = 0; c < 4; ++c) o[c] = __builtin_amdgcn_mfma_f32_32x32x16_bf16(vf[c], pf[kq], o[c], 0, 0, 0);
        __builtin_amdgcn_s_setprio(0);
        __builtin_amdgcn_sched_barrier(0);
    }
}
__device__ __forceinline__ void attn_step(const LAS unsigned char* sb, const LAS unsigned char* sb_prev, int kt, int qb, int qabs, int qmax_w, int map, int pir, int r32, int hi, float cb, const bf16x8 (&qf)[4],
                                          f32x16 (&o)[4], float& mref, float& lrun, bool& mset, bf16x8 (&pf)[4], bool& pend) {
    const bool have = 64 * kt <= qmax_w;
    f32x16 p0, p1;
    if (pend) attn_pv(sb_prev, r32, hi, pf, o);
    pend = false;
    if (have) {
        attn_scores(sb, kt, qabs, map, pir, hi, cb, mref, qf, p0, p1);
        attn_softmax(kt, qb, qabs, hi, p0, p1, o, mref, lrun, mset, pf);
        if (map == 0) attn_pv(sb, r32, hi, pf, o); else pend = true;
    }
}
#define LBAR() do { asm volatile("s_waitcnt lgkmcnt(0)" ::: "memory"); __builtin_amdgcn_s_barrier(); asm volatile("" ::: "memory"); } while (0)
__device__ __forceinline__ void attn_unit(LAS unsigned char* lds, const bf16_t* Q, const bf16_t* Kg, const bf16_t* Vt, bf16_t* Y, int b, int h, int qb, float cb, float lam, const float* subgain, float outscale) {
    using namespace att;
    int tid_ = threadIdx.x; asm volatile("" : "+v"(tid_));
    const int tid = tid_, lane = tid & 63, wid = __builtin_amdgcn_readfirstlane(tid >> 6), map = wid >> 2, g = wid & 3, r32 = lane & 31, hi = lane >> 5;
    const size_t rowbase = (size_t)b * SEQ; const int q0 = qb * 128, qabs = q0 + 32 * g + r32;
    const int nt = 2 * qb + 2;
    const int krow = tid >> 4, kch = tid & 15, vrow = tid >> 3, vch = tid & 7;
    const bf16_t* kg = Kg + (rowbase + krow) * 512 + h * 128 + kch * 8;
    const bf16_t* vg = Vt + ((size_t)(b * 4 + h) * 128 + vrow) * 2048 + vch * 8;
    const int klds = (kch >> 3) * K_BYTES + krow * KSTR + (kch & 7) * 16, vlds = 2 * K_BYTES + vrow * KSTR + vch * 16;
    u32x4 Ak0, Ak1, Av0, Av1, Bk0, Bk1, Bv0, Bv1;
#define ATT_GLOAD(S, j) do { const int kt_ = (nt - 1 - (j)) > 0 ? (nt - 1 - (j)) : 0; \
                              S##k0 = *(const u32x4*)(kg + (size_t)kt_ * 64 * 512); S##k1 = *(const u32x4*)(kg + (size_t)kt_ * 64 * 512 + 32 * 512); \
                              S##v0 = *(const u32x4*)(vg + kt_ * 64); S##v1 = *(const u32x4*)(vg + kt_ * 64 + (size_t)64 * 2048); } while (0)
#define ATT_LSTORE(S, sb_) do { *(LAS u32x4*)((sb_) + klds) = S##k0; *(LAS u32x4*)((sb_) + klds + 32 * KSTR) = S##k1; \
                                *(LAS u32x4*)((sb_) + vlds) = S##v0; *(LAS u32x4*)((sb_) + vlds + 64 * KSTR) = S##v1; } while (0)
    bf16x8 qf[4];
    { const bf16_t* qp = Q + (rowbase + qabs) * 512 + h * 128 + map * 64 + hi * 8;
#pragma unroll
      for (int d0 = 0; d0 < 4; ++d0) qf[d0] = *(const bf16x8*)(qp + d0 * 16); }
    ATT_GLOAD(A, 0); ATT_GLOAD(B, 1);
    __builtin_amdgcn_s_waitcnt(0x0F74);
    f32x16 o[4];
#pragma unroll
    for (int c = 0; c < 4; ++c)
#pragma unroll
        for (int r = 0; r < 16; ++r) o[c][r] = 0.f;
    float mref = 0.f, lrun = 0.f; bool mset = false, pend = false;
    bf16x8 pf[4];
#pragma unroll
    for (int i = 0; i < 4; ++i) pf[i] = (bf16x8){0, 0, 0, 0, 0, 0, 0, 0};
    const int pir = (r32 & 19) | ((r32 & 4) << 1) | ((r32 & 8) >> 1);
    const int qmax_w = q0 + 32 * g + 31;
    LAS unsigned char* s_prev = lds + 2 * STAGE; LAS unsigned char* s_cur = lds; LAS unsigned char* s_next = lds + STAGE;
#define ATT_ROT() do { LAS unsigned char* t_ = s_prev; s_prev = s_cur; s_cur = s_next; s_next = t_; } while (0)
    ATT_LSTORE(A, s_cur); LBAR();
    for (int j = 0; j < nt; j += 2) {
        ATT_GLOAD(A, j + 2);
        attn_step(s_cur, s_prev, nt - 1 - j, qb, qabs, qmax_w, map, pir, r32, hi, cb, qf, o, mref, lrun, mset, pf, pend);
        ATT_LSTORE(B, s_next); LBAR(); ATT_ROT();
        ATT_GLOAD(B, j + 3);
        attn_step(s_cur, s_prev, nt - 2 - j, qb, qabs, qmax_w, map, pir, r32, hi, cb, qf, o, mref, lrun, mset, pf, pend);
        ATT_LSTORE(A, s_next); LBAR(); ATT_ROT();
    }
    if (map == 1 && pend) attn_pv(s_prev, r32, hi, pf, o);
    LBAR();
#undef ATT_ROT
#undef ATT_GLOAD
#undef ATT_LSTORE
    const float ltot = lrun + __shfl_xor(lrun, 32), inv = 1.0f / ltot;
    LAS float* comb = (LAS float*)(lds + COMB_OFF) + g * 4096 + r32;
    if (map == 1) {
        const float f = lam * inv;
#pragma unroll
        for (int c = 0; c < 4; ++c)
#pragma unroll
            for (int r = 0; r < 16; ++r) comb[(32 * c + (r & 3) + 8 * (r >> 2) + 4 * hi) * 32] = o[c][r] * f;
    }
    f32x4 gn[16];
#pragma unroll
    for (int c = 0; c < 4; ++c)
#pragma unroll
        for (int j = 0; j < 4; ++j) gn[c * 4 + j] = *(const f32x4*)(subgain + 32 * c + 8 * j + 4 * hi);
    LBAR();
    if (map == 0) {
        float ss = 0.f;
#pragma unroll
        for (int c = 0; c < 4; ++c)
#pragma unroll
            for (int r = 0; r < 16; ++r) { const float v = o[c][r] * inv - comb[(32 * c + (r & 3) + 8 * (r >> 2) + 4 * hi) * 32]; o[c][r] = v; ss += v * v; }
        ss += __shfl_xor(ss, 32);
        const float rstd = __builtin_amdgcn_rsqf(ss * (1.0f / 128.0f) + 1e-6f) * outscale;
        bf16_t* yp = Y + (rowbase + qabs) * 1024 + 512 + h * 128 + 4 * hi;
#pragma unroll
        for (int c = 0; c < 4; ++c)
#pragma unroll
            for (int j = 0; j < 4; ++j) {
                const f32x4 gq = gn[c * 4 + j];
                u32x2 w; w.x = cvtpk(o[c][4 * j + 0] * rstd * gq[0], o[c][4 * j + 1] * rstd * gq[1]); w.y = cvtpk(o[c][4 * j + 2] * rstd * gq[2], o[c][4 * j + 3] * rstd * gq[3]);
                *(u32x2*)(yp + 32 * c + 8 * j) = w;
            }
    }
    LBAR();
}

__global__ void __launch_bounds__(NTHREADS, 2) hybrid_fwd(Args a) {
    extern __shared__ __attribute__((aligned(16))) unsigned char lds_raw[];
    LAS unsigned char* lds = (LAS unsigned char*)lds_raw;
    cg::grid_group grid = cg::this_grid();
    const int G = gridDim.x, bx = blockIdx.x, vcu = (G % 8 == 0) ? (bx % 8) * (G / 8) + bx / 8 : bx;
    unsigned char* ws = a.ws;
    if (threadIdx.x < 16) ((LAS unsigned*)(lds + LDS_BYTES - 64))[threadIdx.x] = 0u;
    __syncthreads();
    const XcdBarrier bar = xcd_barrier_post((unsigned*)(ws + WS_CTL), (volatile LAS unsigned*)(lds + LDS_BYTES - 64));
    float* X = (float*)(ws + WS_X); bf16_t* XB = (bf16_t*)(ws + WS_XB); float* RS = (float*)(ws + WS_RS);
    bf16_t* ACT = (bf16_t*)(ws + WS_ACT); bf16_t* Zb = (bf16_t*)(ws + WS_Z); bf16_t* Qb = (bf16_t*)(ws + WS_Q); bf16_t* Kb = (bf16_t*)(ws + WS_K); bf16_t* Vtb = (bf16_t*)(ws + WS_VT); bf16_t* Yb = (bf16_t*)(ws + WS_Y);

#ifndef NO_PRO
    for (int rep_ = 0; rep_ < PROBE_PRO_REPS; ++rep_) { int t_ = threadIdx.x; asm volatile("" : "+v"(t_)); prologue(a, lds, vcu, G, __builtin_amdgcn_readfirstlane(t_ >> 6), t_ & 63); }
#endif
    grid.sync();
    xcd_barrier(bar);

#pragma unroll 1
#define PRE_B(BT, NN, KK) do { __syncthreads(); pg8::gemm_pre_b(lds, (const bf16_t*)(BT), M, (NN), (KK), G, bx); } while (0)
    for (int st = 0; st < 3 * DEPTH; ++st) {
        const int l = st / 3, sub = st - 3 * l;
        unsigned char* wl = ws + WS_W + (size_t)l * L_STRIDE;
        const float* rs_in = RS + (size_t)(st & 1) * M * 16; float* rs_out = RS + (size_t)((st + 1) & 1) * M * 16;
        if (sub != 1) {
            for (int rep_ = 0; rep_ < PROBE_G1_REPS; ++rep_) {
                pg8::Gemm gm{XB, (const bf16_t*)(wl + (sub ? LO_WGU2 : LO_WGU1)), M, 2 * DFF, DM}; pg8::StaticOrder S; S.init(M, 2 * DFF, G, bx);
                pg8::EpiSwiglu E{ACT, DFF, rs_in};
#ifndef NO_G1
                pg8::gemm_phase<pg8::EpiSwiglu, pg8::StaticOrder, true, true>(lds, gm, S, E, st != 0);
#endif
                int cl_ = 0, s0_ = 0, s1_ = 0;
                if (G == 256 && bx >= 128 && slot_range(l, sub ? 2 : 0, cl_, s0_, s1_)) {
                    int t_ = threadIdx.x; asm volatile("" : "+v"(t_));
                    convert_items(a, lds, cl_, s0_, s1_, (bx - 128) * NWAVES + __builtin_amdgcn_readfirstlane(t_ >> 6), 128 * NWAVES, __builtin_amdgcn_readfirstlane(t_ >> 6), t_ & 63);
                }
            }
            if (st != 0) PRE_B(wl + (sub ? LO_WD2 : LO_WD1), DM, DFF);
            for (int rb_ = 0; rb_ < PROBE_BAR_REPS; ++rb_) xcd_barrier(bar);
            {
                pg8::Gemm gm{ACT, (const bf16_t*)(wl + (sub ? LO_WD2 : LO_WD1)), M, DM, DFF}; pg8::StaticOrder S; S.init(M, DM, G, bx);
                pg8::EpiResid E{st == 0 ? a.in[I_X] : (const float*)X, X, XB, rs_out, 0.5f};
#ifndef NO_G2
                pg8::gemm_phase<pg8::EpiResid, pg8::StaticOrder, true, true>(lds, gm, S, E, st != 0);
#endif
            }
            if (st + 1 < 3 * DEPTH) {
                if (sub == 0) PRE_B(wl + LO_WIN, NIN, DM); else PRE_B(ws + WS_W + (size_t)(l + 1) * L_STRIDE + LO_WGU1, 2 * DFF, DM);
            }
            for (int rb_ = 0; rb_ < PROBE_BAR_REPS; ++rb_) xcd_barrier(bar);
        } else {
            for (int rep_ = 0; rep_ < PROBE_G3_REPS; ++rep_) {
                pg8::Gemm gm{XB, (const bf16_t*)(wl + LO_WIN), M, NIN, DM}; pg8::StaticOrder S; S.init(M, NIN, G, bx);
                pg8::EpiWin E{Zb, Qb, Kb, Vtb, rs_in, 0.125f * 1.4426950408889634f};
#ifndef NO_G3
                pg8::gemm_phase<pg8::EpiWin, pg8::StaticOrder, true, true>(lds, gm, S, E, true);
#endif
                int cl_ = 0, s0_ = 0, s1_ = 0;
                if (G == 256 && bx >= 128 && slot_range(l, 1, cl_, s0_, s1_)) {
                    int t_ = threadIdx.x; asm volatile("" : "+v"(t_));
                    convert_items(a, lds, cl_, s0_, s1_, (bx - 128) * NWAVES + __builtin_amdgcn_readfirstlane(t_ >> 6), 128 * NWAVES, __builtin_amdgcn_readfirstlane(t_ >> 6), t_ & 63);
                }
            }
            for (int rb_ = 0; rb_ < PROBE_BAR_REPS; ++rb_) xcd_barrier(bar);
            for (int rep_ = 0; rep_ < PROBE_MIX_REPS; ++rep_) {
                const bf16_t* sw = (const bf16_t*)(wl + LO_SGUW);
                for (int rs_ = 0; rs_ < PROBE_SGU_REPS; ++rs_)
                for (int ui = vcu; ui < NB * 16 * 8; ui += G) {
                    const int g = ui & 7, c = (ui >> 3) & 15, b = ui >> 7;
#ifndef NO_SGU
                    sgu_unit(lds, Zb, sw + (size_t)g * 128 * 128, a.in[I_SGUN] + (size_t)l * 512 + g * 64, a.in[I_SGUB] + (size_t)l * 1024 + g * 128, Yb, b, c, g);
#endif
                }
                int t_ = threadIdx.x; asm volatile("" : "+v"(t_)); const int lane = t_ & 63;
                float lam_init = 0.8f - 0.6f * expf(-0.3f * (float)l);
                const float d1 = wave_sum(a.in[I_LQ1][l * 64 + lane] * a.in[I_LK1][l * 64 + lane]), d2 = wave_sum(a.in[I_LQ2][l * 64 + lane] * a.in[I_LK2][l * 64 + lane]);
                const float lam = expf(d1) - expf(d2) + lam_init;
                for (int ra_ = 0; ra_ < PROBE_ATT_REPS; ++ra_)
                for (int pi = vcu; pi < NB * 4 * 8; pi += G) {
                    const int bh = pi >> 3, s = pi & 7, b = bh >> 2, h = bh & 3;
                    const float cb = exp2f(-2.0f * (float)(h + 1)) * 1.4426950408889634f;
#pragma unroll 1
                    for (int i = 0; i < 2; ++i)
                    {
#ifndef NO_ATT
                        attn_unit(lds, Qb, Kb, Vtb, Yb, b, h, i ? 15 - s : s, cb, lam, a.in[I_SUBLN] + (size_t)l * 128, 1.0f - lam_init);
#endif
                    }
                }
            }
            PRE_B(wl + LO_WOUT, DM, DM);
            for (int rb_ = 0; rb_ < PROBE_BAR_REPS; ++rb_) xcd_barrier(bar);
            {
                pg8::Gemm gm{Yb, (const bf16_t*)(wl + LO_WOUT), M, DM, DM}; pg8::StaticOrder S; S.init(M, DM, G, bx);
                pg8::EpiResid E{X, X, XB, rs_out, 1.0f};
#ifndef NO_G4
                pg8::gemm_phase<pg8::EpiResid, pg8::StaticOrder, true, true>(lds, gm, S, E, true);
#endif
            }
            PRE_B(wl + LO_WGU2, 2 * DFF, DM);
            for (int rb_ = 0; rb_ < PROBE_BAR_REPS; ++rb_) xcd_barrier(bar);
        }
    }
#undef PRE_B
    {
        int t_ = threadIdx.x; asm volatile("" : "+v"(t_)); const int lane = t_ & 63, wave = __builtin_amdgcn_readfirstlane(t_ >> 6);
        const float* rs = RS; const float* fg = a.in[I_FINN];
        const int gw = vcu * NWAVES + wave, NGW = G * NWAVES;
        f32x4 gn[4];
#pragma unroll
        for (int j = 0; j < 4; ++j) gn[j] = *((const f32x4*)fg + lane + 64 * j);
        for (int m = gw; m < M; m += NGW) {
            float sq = 0.f;
#pragma unroll
            for (int q4 = 0; q4 < 4; ++q4) { const f32x4 pv = *(const f32x4*)(rs + (size_t)m * 16 + 4 * q4); sq += (pv[0] + pv[1]) + (pv[2] + pv[3]); }
            const float r = __builtin_amdgcn_rsqf(sq * (1.0f / 1024.0f) + 1e-6f);
            const f32x4* xr = (const f32x4*)(X + (size_t)m * DM) + lane; f32x4* orow = (f32x4*)(a.out + (size_t)m * DM) + lane;
#pragma unroll
            for (int j = 0; j < 4; ++j) orow[64 * j] = xr[64 * j] * r * gn[j];
        }
    }
}

extern "C" void kernel_launch(void* const* d_in, const int* in_sizes, int n_in, void* d_out, int out_size, void* d_ws, size_t ws_size, hipStream_t stream) {
    static int grid = 0;
    if (grid == 0) {
        if (n_in != 21 || out_size != M * DM || ws_size < WS_END) { fprintf(stderr, "kernel_launch: unexpected problem (n_in %d, out %d, ws %zu, need %zu)\n", n_in, out_size, ws_size, (size_t)WS_END); grid = -1; return; }
        int dev = 0, cus = 0, per_cu = 0;
        hipGetDevice(&dev); hipDeviceGetAttribute(&cus, hipDeviceAttributeMultiprocessorCount, dev);
        if (hipFuncSetAttribute((const void*)hybrid_fwd, hipFuncAttributeMaxDynamicSharedMemorySize, LDS_BYTES) != hipSuccess) { fprintf(stderr, "kernel_launch: hipFuncSetAttribute failed\n"); grid = -1; return; }
        if (hipOccupancyMaxActiveBlocksPerMultiprocessor(&per_cu, (const void*)hybrid_fwd, NTHREADS, LDS_BYTES) != hipSuccess || per_cu < 1) { fprintf(stderr, "kernel_launch: occupancy query says %d\n", per_cu); per_cu = 1; }
        (void)hipGetLastError();
        grid = cus * per_cu;
    }
    if (grid < 0) return;
    if (hipMemsetAsync((unsigned char*)d_ws + WS_CTL, 0, CTL_BYTES, stream) != hipSuccess) { fprintf(stderr, "kernel_launch: memset failed\n"); return; }
    Args a{};
    for (int i = 0; i < 21; ++i) a.in[i] = (const float*)d_in[i];
    a.out = (float*)d_out; a.ws = (unsigned char*)d_ws;
    void* args[] = {&a};
    hipError_t e = hipLaunchCooperativeKernel((const void*)hybrid_fwd, dim3(grid), dim3(NTHREADS), args, LDS_BYTES, stream);
    if (e != hipSuccess) fprintf(stderr, "cooperative launch failed: %s (grid %d)\n", hipGetErrorString(e), grid);
}
```

```cpp
#include <hip/hip_runtime.h>
#include <hip/hip_cooperative_groups.h>
#include <cstdio>
#include <cstdint>
namespace cg = cooperative_groups;
namespace pg8 {
#define PG8_LAS __attribute__((address_space(3)))
typedef unsigned short bf16_t;
typedef short bf16x8 __attribute__((ext_vector_type(8)));
typedef float f32x4 __attribute__((ext_vector_type(4)));
typedef unsigned u32x4 __attribute__((ext_vector_type(4)));
constexpr int BM = 256, BK = 64, HALF = 128, HTB = HALF * BK * 2  , STAGE_BYTES = 8 * HTB, NXCD = 8, WGM = 8;

__host__ __device__ __forceinline__ int lds_byte(int r, int c) { const int st = (r >> 4) * 2 + (c >> 5), rr = r & 15, cc = c & 31, ob = rr * 64 + cc * 2; return st * 1024 + (ob ^ (((ob >> 9) & 1) << 5)); }
__host__ __device__ __forceinline__ void stage_rc(int b, int& R, int& C) { const int st = b / 1024, sb = b % 1024, swz = sb ^ (((sb >> 9) & 1) << 5); R = (st >> 1) * 16 + swz / 64; C = (st & 1) * 32 + (swz % 64) / 2; }
__host__ __device__ __forceinline__ int perm32(int rho) { const int n = rho >> 4, i = rho & 15; return 8 * (i >> 2) + 4 * n + (i & 3); }

struct Unit { int pm, pn; };
struct Gemm { const bf16_t* A; const bf16_t* Bt; int M, N, K; };

struct StaticOrder {
    int nM, nN, nwg, G, c;
    __host__ __device__ void init(int M, int N, int G_, int c_) { nM = M / BM; nN = N / BM; nwg = nM * nN; G = G_; c = c_; }
    __host__ __device__ bool next(int i, Unit& u) const {
        const long L = (long)i * G + c; if (L >= nwg) return false;
        int wgid = (int)L; { const int q = nwg / NXCD, r = nwg % NXCD, xcd = wgid % NXCD, off = wgid / NXCD; wgid = (xcd < r ? xcd * (q + 1) : r * (q + 1) + (xcd - r) * q) + off; }
        const int nig = WGM * nN, gid = wgid / nig, fm = gid * WGM, gsz = (nM - fm) < WGM ? (nM - fm) : WGM;
        u.pm = fm + ((wgid % nig) % gsz); u.pn = (wgid % nig) / gsz; return true;
    }
    __device__ __forceinline__ void a_ready(const Unit&) const {}
    __device__ __forceinline__ void done(const Unit&) const {}
};

typedef float f32x2c_t __attribute__((ext_vector_type(2))); typedef __bf16 bf16x2c_t __attribute__((ext_vector_type(2)));
__device__ __forceinline__ unsigned cvt_pk_bf16(float lo, float hi) { f32x2c_t v = {lo, hi}; bf16x2c_t b = __builtin_convertvector(v, bf16x2c_t); return __builtin_bit_cast(unsigned, b); }
typedef float f32x2 __attribute__((ext_vector_type(2)));
__device__ __forceinline__ f32x2 gelu_pk(f32x2 v) {
    const f32x2 av = __builtin_elementwise_abs(v), d = av * 0.2316418882f + 1.0f;
    f32x2 t; t.x = __builtin_amdgcn_rcpf(d.x); t.y = __builtin_amdgcn_rcpf(d.y);
    f32x2 q = t * 0.5307027145f + (-0.7265760135f); q = q * t + 0.7107068705f; q = q * t + (-0.142248368f); q = q * t + 0.127414796f; q = q * t;
    const f32x2 s = (v * v) * (-0.72134752044f);
    f32x2 e; e.x = __builtin_amdgcn_exp2f(s.x); e.y = __builtin_amdgcn_exp2f(s.y);
    const f32x2 m = v * (q * e), r = v - m;
    f32x2 o; o.x = v.x < 0.f ? m.x : r.x; o.y = v.y < 0.f ? m.y : r.y; return o;
}

__device__ __forceinline__ unsigned short f2bf1(float f) { unsigned u = __builtin_bit_cast(unsigned, f); return (unsigned short)((u + 0x7fffu + ((u >> 16) & 1u)) >> 16); }
constexpr float RMS_EPS = 1e-6f;
__device__ __forceinline__ float xsum16(float v) { const auto r = __builtin_amdgcn_permlane16_swap(__builtin_bit_cast(unsigned, v), __builtin_bit_cast(unsigned, v), false, false); return __builtin_bit_cast(float, (unsigned)r[0]) + __builtin_bit_cast(float, (unsigned)r[1]); }
__device__ __forceinline__ float xsum32(float v) { const auto r = __builtin_amdgcn_permlane32_swap(__builtin_bit_cast(unsigned, v), __builtin_bit_cast(unsigned, v), false, false); return __builtin_bit_cast(float, (unsigned)r[0]) + __builtin_bit_cast(float, (unsigned)r[1]); }
__device__ __forceinline__ void row_rstd8(const float* rowss, int row0, int fq, float (&rsv)[2][4]) {
    f32x4 pv[2][4];
#pragma unroll
    for (int ai = 0; ai < 2; ++ai)
#pragma unroll
        for (int m = 0; m < 4; ++m) pv[ai][m] = *(const f32x4*)(rowss + (size_t)(row0 + ai * HALF + m * 16) * 16 + 4 * fq);
#pragma unroll
    for (int ai = 0; ai < 2; ++ai)
#pragma unroll
        for (int m = 0; m < 4; ++m) rsv[ai][m] = (pv[ai][m][0] + pv[ai][m][1]) + (pv[ai][m][2] + pv[ai][m][3]);
#pragma unroll
    for (int ai = 0; ai < 2; ++ai)
#pragma unroll
        for (int m = 0; m < 4; ++m) rsv[ai][m] = xsum16(rsv[ai][m]);
#pragma unroll
    for (int ai = 0; ai < 2; ++ai)
#pragma unroll
        for (int m = 0; m < 4; ++m) rsv[ai][m] = xsum32(rsv[ai][m]);
#pragma unroll
    for (int ai = 0; ai < 2; ++ai)
#pragma unroll
        for (int m = 0; m < 4; ++m) rsv[ai][m] = __builtin_amdgcn_rsqf(rsv[ai][m] * (1.0f / 1024.0f) + RMS_EPS);
}
__device__ __forceinline__ float row_rstd(const float* rowss, int row, int fq) {
    const f32x4 pv = *(const f32x4*)(rowss + (size_t)row * 16 + 4 * fq);
    float s = (pv[0] + pv[1]) + (pv[2] + pv[3]);
    s += __shfl_xor(s, 16); s += __shfl_xor(s, 32);
    return __builtin_amdgcn_rsqf(s * (1.0f / 1024.0f) + RMS_EPS);
}
struct EpiSwiglu {
    static constexpr bool PERM = true, AFTER_DRAIN = false;
    bf16_t* O; int ldo; const float* rowss;
    __device__ __forceinline__ void operator()(const f32x4 (&acc)[2][2][4][2], const Unit& u, int wr, int wc, int fr, int fq) const {
        const int row0 = u.pm * BM + wr * 64 + fr, col0 = u.pn * HALF + wc * 32 + 8 * fq;
        float rsv[2][4]; row_rstd8(rowss, row0, fq, rsv);
#pragma unroll
        for (int ai = 0; ai < 2; ++ai)
#pragma unroll
            for (int m = 0; m < 4; ++m) {
                const int row = row0 + ai * HALF + m * 16;
                const float rs = rsv[ai][m];
                float o[8]; const float rs2 = rs * rs, nrs = rs * -1.4426950408889634f;
#pragma unroll
                for (int n = 0; n < 2; ++n) {
                    const f32x4 t = (acc[ai][0][m][n] * acc[ai][1][m][n]) * rs2, ea = acc[ai][0][m][n] * nrs;
#pragma unroll
                    for (int e = 0; e < 4; ++e) o[n * 4 + e] = t[e] * __builtin_amdgcn_rcpf(1.0f + __builtin_amdgcn_exp2f(ea[e]));
                }
                u32x4 w; w.x = cvt_pk_bf16(o[0], o[1]); w.y = cvt_pk_bf16(o[2], o[3]); w.z = cvt_pk_bf16(o[4], o[5]); w.w = cvt_pk_bf16(o[6], o[7]);
                *(u32x4*)(O + (size_t)row * ldo + col0) = w;
            }
    }
};
struct EpiResid {
    static constexpr bool PERM = true, AFTER_DRAIN = false;
    const float* Xin; float* X; bf16_t* XB; float* rowss_next; float scale;
    __device__ __forceinline__ void operator()(const f32x4 (&acc)[2][2][4][2], const Unit& u, int wr, int wc, int fr, int fq) const {
        const int row0 = u.pm * BM + wr * 64 + fr, col0 = u.pn * BM + wc * 32 + 8 * fq;
#pragma unroll
        for (int ai = 0; ai < 2; ++ai)
#pragma unroll
          for (int mh = 0; mh < 2; ++mh) {
            f32x4 xv[2][2][2];
#pragma unroll
            for (int mm = 0; mm < 2; ++mm)
#pragma unroll
                for (int bj = 0; bj < 2; ++bj) {
                    const float* xi = Xin + (size_t)(row0 + ai * HALF + (2 * mh + mm) * 16) * 1024 + col0 + bj * HALF;
                    xv[mm][bj][0] = *(const f32x4*)xi; xv[mm][bj][1] = *(const f32x4*)(xi + 4);
                }
#pragma unroll
            for (int mm = 0; mm < 2; ++mm) {
                const int m = 2 * mh + mm;
                const int row = row0 + ai * HALF + m * 16;
                float ss = 0.f;
#pragma unroll
                for (int bj = 0; bj < 2; ++bj) {
                    float* xp = X + (size_t)row * 1024 + col0 + bj * HALF;
                    const f32x4 x0 = xv[mm][bj][0] + acc[ai][bj][m][0] * scale, x1 = xv[mm][bj][1] + acc[ai][bj][m][1] * scale;
                    *(f32x4*)xp = x0; *(f32x4*)(xp + 4) = x1;
                    ss += (x0[0] * x0[0] + x0[1] * x0[1]) + (x0[2] * x0[2] + x0[3] * x0[3]) + (x1[0] * x1[0] + x1[1] * x1[1]) + (x1[2] * x1[2] + x1[3] * x1[3]);
                    u32x4 w; w.x = cvt_pk_bf16(x0[0], x0[1]); w.y = cvt_pk_bf16(x0[2], x0[3]); w.z = cvt_pk_bf16(x1[0], x1[1]); w.w = cvt_pk_bf16(x1[2], x1[3]);
                    *(u32x4*)(XB + (size_t)row * 1024 + col0 + bj * HALF) = w;
                }
                ss = xsum32(xsum16(ss));
                if (fq == 0) rowss_next[(size_t)row * 16 + u.pn * 4 + wc] = ss;
            }
          }
    }
};
struct EpiWin {
    static constexpr bool PERM = true, AFTER_DRAIN = false;
    bf16_t *Z, *Q, *Kb, *Vt; const float* rowss; float qscale;
    __device__ __forceinline__ void operator()(const f32x4 (&acc)[2][2][4][2], const Unit& u, int wr, int wc, int fr, int fq) const {
        const int row0 = u.pm * BM + wr * 64 + fr, cw = wc * 32 + 8 * fq;
        float rsv[2][4]; row_rstd8(rowss, row0, fq, rsv);
#pragma unroll
        for (int ai = 0; ai < 2; ++ai)
#pragma unroll
            for (int m = 0; m < 4; ++m) {
                const int row = row0 + ai * HALF + m * 16;
                const float rs = rsv[ai][m];
                if (u.pn < 4) {
#pragma unroll
                    for (int bj = 0; bj < 2; ++bj) {
                        const f32x4 v0 = acc[ai][bj][m][0] * rs, v1 = acc[ai][bj][m][1] * rs;
                        const f32x2 a = gelu_pk((f32x2){v0[0], v0[1]}), b = gelu_pk((f32x2){v0[2], v0[3]}), c = gelu_pk((f32x2){v1[0], v1[1]}), d = gelu_pk((f32x2){v1[2], v1[3]});
                        u32x4 w; w.x = cvt_pk_bf16(a.x, a.y); w.y = cvt_pk_bf16(b.x, b.y); w.z = cvt_pk_bf16(c.x, c.y); w.w = cvt_pk_bf16(d.x, d.y);
                        *(u32x4*)(Z + (size_t)row * 1024 + u.pn * BM + bj * HALF + cw) = w;
                    }
                } else if (u.pn < 8) {
                    bf16_t* base = (u.pn < 6) ? Q : Kb; const float sc = (u.pn < 6) ? rs * qscale : rs; const int ct = (u.pn & 1) * BM;
#pragma unroll
                    for (int bj = 0; bj < 2; ++bj) {
                        const f32x4 v0 = acc[ai][bj][m][0] * sc, v1 = acc[ai][bj][m][1] * sc;
                        u32x4 w; w.x = cvt_pk_bf16(v0[0], v0[1]); w.y = cvt_pk_bf16(v0[2], v0[3]); w.z = cvt_pk_bf16(v1[0], v1[1]); w.w = cvt_pk_bf16(v1[2], v1[3]);
                        *(u32x4*)(base + (size_t)row * 512 + ct + bj * HALF + cw) = w;
                    }
                } else {
                    const int b = row >> 11, s = row & 2047;
#pragma unroll
                    for (int bj = 0; bj < 2; ++bj) {
                        const int h = 2 * (u.pn - 8) + bj;
                        bf16_t* vp = Vt + ((size_t)(b * 4 + h) * 128 + cw) * 2048 + s;
#pragma unroll
                        for (int n = 0; n < 2; ++n)
#pragma unroll
                            for (int e = 0; e < 4; ++e) vp[(size_t)(n * 4 + e) * 2048] = f2bf1(acc[ai][bj][m][n][e] * rs);
                    }
                }
            }
    }
};
template <class Epi, class Sched, bool ALIGN_EPI = false, bool SP2 = false>
__device__ __forceinline__ void gemm_phase(PG8_LAS unsigned char* lds, const Gemm g, const Sched& S, const Epi& E) {
    int tid_ = threadIdx.x; asm volatile("" : "+v"(tid_));
    const int tid = tid_, wid = __builtin_amdgcn_readfirstlane(tid >> 6), lane = tid & 63, wr = wid >> 2, wc = wid & 3, fr = lane & 15, fq = lane >> 4;
    const int K = g.K, nt = K / BK;
    unsigned voffA[2], voffB[2];
#pragma unroll
    for (int i = 0; i < 2; ++i) { int R, C; stage_rc(tid * 16 + i * 8192, R, C); const int Rb = Epi::PERM ? ((R & ~31) + perm32(R & 31)) : R;
        voffA[i] = (unsigned)(R * K + C) * 2u; voffB[i] = (unsigned)(Rb * K + C) * 2u; }
    const size_t kstep = (size_t)(BK * 2);
    const size_t hstep = (size_t)HALF * K * 2;
    const size_t tstep = 2 * hstep;
    const unsigned ldsw = (unsigned)wid * 1024u;
    const int aoff = lds_byte(wr * 64 + fr, fq * 8), boff = lds_byte(wc * 32 + fr, fq * 8);
#define PG8_SA(b, h) (((b) * 2 + (h)) * HTB)
#define PG8_SB(b, h) ((4 + (b) * 2 + (h)) * HTB)
#define PG8_STAGE(bufoff, gbase, voff) do { _Pragma("unroll") for (int _i = 0; _i < 2; ++_i) \
        __builtin_amdgcn_global_load_lds((const unsigned*)((const char*)(gbase) + (voff)[_i]), (PG8_LAS unsigned*)(lds + (bufoff) + ldsw + _i * 8192), 16, 0, 0); } while (0)
#define PG8_LDA(dst, b, h) do { _Pragma("unroll") for (int m = 0; m < 4; ++m) _Pragma("unroll") for (int k = 0; k < 2; ++k) dst[m][k] = *(const PG8_LAS bf16x8*)(lds + PG8_SA(b, h) + aoff + m * 2048 + k * 1024); } while (0)
#define PG8_LDB(dst, b, h) do { _Pragma("unroll") for (int n = 0; n < 2; ++n) _Pragma("unroll") for (int k = 0; k < 2; ++k) dst[n][k] = *(const PG8_LAS bf16x8*)(lds + PG8_SB(b, h) + boff + n * 2048 + k * 1024); } while (0)
#define PG8_MMA(ai, bj, At, Bt) do { __builtin_amdgcn_s_setprio(1); _Pragma("unroll") for (int m = 0; m < 4; ++m) _Pragma("unroll") for (int n = 0; n < 2; ++n) _Pragma("unroll") for (int k = 0; k < 2; ++k) \
        acc[ai][bj][m][n] = __builtin_amdgcn_mfma_f32_16x16x32_bf16(Bt[n][k], At[m][k], acc[ai][bj][m][n], 0, 0, 0); __builtin_amdgcn_s_setprio(0); } while (0)
#define PG8_WAIT_V(n) asm volatile("s_waitcnt vmcnt(" #n ")" ::: "memory")
#define PG8_WAIT_L(n) asm volatile("s_waitcnt lgkmcnt(" #n ")" ::: "memory")
#define PG8_BAR __builtin_amdgcn_s_barrier()
#define PG8_SCHED __builtin_amdgcn_sched_barrier(0)
    Unit cur, nxt; int ui = 0;
    if (!S.next(0, cur)) return;
    f32x4 acc[2][2][4][2];
#pragma unroll
    for (int a = 0; a < 2; ++a)
#pragma unroll
        for (int b = 0; b < 2; ++b)
#pragma unroll
            for (int m = 0; m < 4; ++m)
#pragma unroll
                for (int n = 0; n < 2; ++n) acc[a][b][m][n] = (f32x4){0.f, 0.f, 0.f, 0.f};
    bf16x8 At[4][2], B0[2][2], B1[2][2];
    const char* cA = (const char*)g.A + (size_t)cur.pm * tstep; const char* cB = (const char*)g.Bt + (size_t)cur.pn * tstep;
    S.a_ready(cur);
    if constexpr (SP2) {
        PG8_STAGE(PG8_SB(0, 0), cB, voffB); PG8_STAGE(PG8_SB(0, 1), cB + hstep, voffB); PG8_STAGE(PG8_SA(0, 0), cA, voffA); PG8_STAGE(PG8_SA(0, 1), cA + hstep, voffA);
        if (wr == 1) PG8_BAR;
        PG8_WAIT_V(2); PG8_BAR;
        PG8_STAGE(PG8_SB(1, 0), cB + kstep, voffB); PG8_STAGE(PG8_SA(1, 0), cA + kstep, voffA); PG8_STAGE(PG8_SB(1, 1), cB + hstep + kstep, voffB);
        PG8_WAIT_V(6); PG8_BAR;
    } else {
        PG8_STAGE(PG8_SB(0, 0), cB, voffB); PG8_STAGE(PG8_SA(0, 0), cA, voffA); PG8_STAGE(PG8_SB(0, 1), cB + hstep, voffB); PG8_STAGE(PG8_SA(0, 1), cA + hstep, voffA);
        if (wr == 1) PG8_BAR;
        PG8_WAIT_V(4); PG8_BAR;
        PG8_STAGE(PG8_SB(1, 0), cB + kstep, voffB); PG8_STAGE(PG8_SA(1, 0), cA + kstep, voffA); PG8_STAGE(PG8_SB(1, 1), cB + hstep + kstep, voffB);
        PG8_WAIT_V(6); PG8_BAR;
    }
    for (;;) {
        const bool has_next = S.next(ui + 1, nxt);
        const char* nA = has_next ? (const char*)g.A + (size_t)nxt.pm * tstep : cA; const char* nB = has_next ? (const char*)g.Bt + (size_t)nxt.pn * tstep : cB;
        for (int t = 0; t < nt; t += 2) {
            const bool last = (t == nt - 2);
            const char* a1 = cA + (size_t)(t + 1) * kstep;
            const char* a2 = last ? nA : cA + (size_t)(t + 2) * kstep; const char* b2 = last ? nB : cB + (size_t)(t + 2) * kstep;
            const char* a3 = a2 + kstep; const char* b3 = b2 + kstep;
            if (last && has_next) S.a_ready(nxt);
            if constexpr (SP2) {
            PG8_LDB(B0, 0, 0); PG8_LDB(B1, 0, 1); PG8_SCHED; PG8_LDA(At, 0, 0); PG8_STAGE(PG8_SA(1, 1), a1 + hstep, voffA);
            PG8_WAIT_V(8); PG8_WAIT_L(0); PG8_BAR; PG8_MMA(0, 0, At, B0); PG8_MMA(0, 1, At, B1); PG8_BAR; PG8_SCHED;
            PG8_LDA(At, 0, 1); PG8_STAGE(PG8_SB(0, 0), b2, voffB); PG8_STAGE(PG8_SB(0, 1), b2 + hstep, voffB); PG8_STAGE(PG8_SA(0, 0), a2, voffA);
            PG8_WAIT_V(8); PG8_WAIT_L(0); PG8_BAR; PG8_MMA(1, 0, At, B0); PG8_MMA(1, 1, At, B1); PG8_BAR; PG8_SCHED;
            PG8_LDB(B0, 1, 0); PG8_LDB(B1, 1, 1); PG8_SCHED; PG8_LDA(At, 1, 0); PG8_STAGE(PG8_SA(0, 1), a2 + hstep, voffA);
            PG8_WAIT_V(8); PG8_WAIT_L(0); PG8_BAR; PG8_MMA(0, 0, At, B0); PG8_MMA(0, 1, At, B1); PG8_BAR; PG8_SCHED;
            PG8_LDA(At, 1, 1); PG8_STAGE(PG8_SB(1, 0), b3, voffB); PG8_STAGE(PG8_SB(1, 1), b3 + hstep, voffB); PG8_STAGE(PG8_SA(1, 0), a3, voffA);
            PG8_WAIT_V(8); PG8_WAIT_L(0); PG8_BAR; PG8_MMA(1, 0, At, B0); PG8_MMA(1, 1, At, B1); PG8_BAR; PG8_SCHED;
            } else {
            PG8_LDB(B0, 0, 0); PG8_SCHED; PG8_LDA(At, 0, 0); PG8_STAGE(PG8_SA(1, 1), a1 + hstep, voffA);
            PG8_WAIT_L(8); PG8_BAR; PG8_WAIT_L(0); PG8_MMA(0, 0, At, B0); PG8_BAR; PG8_SCHED;
            PG8_LDB(B1, 0, 1); PG8_STAGE(PG8_SB(0, 0), b2, voffB);
            PG8_BAR; PG8_WAIT_L(0); PG8_MMA(0, 1, At, B1); PG8_BAR;
            PG8_LDA(At, 0, 1); PG8_STAGE(PG8_SA(0, 0), a2, voffA);
            PG8_BAR; PG8_WAIT_L(0); PG8_MMA(1, 0, At, B0); PG8_BAR; PG8_SCHED;
            PG8_STAGE(PG8_SB(0, 1), b2 + hstep, voffB);
            PG8_WAIT_V(6); PG8_BAR; PG8_MMA(1, 1, At, B1); PG8_BAR;
            PG8_LDB(B0, 1, 0); PG8_SCHED; PG8_LDA(At, 1, 0); PG8_STAGE(PG8_SA(0, 1), a2 + hstep, voffA);
            PG8_WAIT_L(8); PG8_BAR; PG8_WAIT_L(0); PG8_MMA(0, 0, At, B0); PG8_BAR; PG8_SCHED;
            PG8_LDB(B1, 1, 1); PG8_STAGE(PG8_SB(1, 0), b3, voffB);
            PG8_BAR; PG8_WAIT_L(0); PG8_MMA(0, 1, At, B1); PG8_BAR;
            PG8_LDA(At, 1, 1); PG8_STAGE(PG8_SA(1, 0), a3, voffA);
            PG8_BAR; PG8_WAIT_L(0); PG8_MMA(1, 0, At, B0); PG8_BAR; PG8_SCHED;
            PG8_STAGE(PG8_SB(1, 1), b3 + hstep, voffB);
            PG8_WAIT_V(6); PG8_BAR; PG8_MMA(1, 1, At, B1); PG8_BAR;
            }
        }
        if constexpr (ALIGN_EPI) { if (wr == 0) PG8_BAR; }
        if constexpr (!Epi::AFTER_DRAIN) { E(acc, cur, wr, wc, fr, fq); S.done(cur); }
        if (!has_next) break;
#pragma unroll
        for (int a = 0; a < 2; ++a)
#pragma unroll
            for (int b = 0; b < 2; ++b)
#pragma unroll
                for (int m = 0; m < 4; ++m)
#pragma unroll
                    for (int n = 0; n < 2; ++n) acc[a][b][m][n] = (f32x4){0.f, 0.f, 0.f, 0.f};
        cur = nxt; cA = nA; cB = nB; ++ui;
        if constexpr (ALIGN_EPI) { if (wr == 1) PG8_BAR; }
    }
    PG8_WAIT_V(0);
    if constexpr (!ALIGN_EPI) { if (wr == 0) PG8_BAR; }
    PG8_BAR;
    if constexpr (Epi::AFTER_DRAIN) { E.fused(acc, cur, wr, wc, fr, fq, lds, wid, lane); S.done(cur); }
#undef PG8_SA
#undef PG8_SB
#undef PG8_STAGE
#undef PG8_LDA
#undef PG8_LDB
#undef PG8_MMA
#undef PG8_WAIT_V
#undef PG8_WAIT_L
#undef PG8_BAR
#undef PG8_SCHED
}
}

#ifndef PROBE_MIX_REPS
#define PROBE_MIX_REPS 1
#endif
#ifndef PROBE_G1_REPS
#define PROBE_G1_REPS 1
#endif
#ifndef PROBE_G3_REPS
#define PROBE_G3_REPS 1
#endif
#ifndef PROBE_PRO_REPS
#define PROBE_PRO_REPS 1
#endif
#ifndef PROBE_BAR_REPS
#define PROBE_BAR_REPS 1
#endif
#ifndef PROBE_SGU_REPS
#define PROBE_SGU_REPS 1
#endif
#ifndef PROBE_ATT_REPS
#define PROBE_ATT_REPS 1
#endif
#define LAS __attribute__((address_space(3)))
using pg8::bf16_t; using pg8::bf16x8; using pg8::f32x4; using pg8::u32x4;
typedef float f32x16 __attribute__((ext_vector_type(16)));
typedef unsigned u32x2 __attribute__((ext_vector_type(2)));
constexpr int DM = 1024, NB = 8, SEQ = 2048, DEPTH = 4, M = NB * SEQ, DFF = 2816, NIN = 2560;
constexpr int NWAVES = 8, NTHREADS = 512;
constexpr int LDS_BYTES = 147456;
constexpr size_t SZ_WGU = (size_t)2 * DFF * DM * 2, SZ_WD = (size_t)DM * DFF * 2, SZ_WIN = (size_t)NIN * DM * 2, SZ_WOUT = (size_t)DM * DM * 2, SZ_SGUW = (size_t)8 * 128 * 128 * 2;
constexpr size_t LO_WGU1 = 0, LO_WD1 = LO_WGU1 + SZ_WGU, LO_WIN = LO_WD1 + SZ_WD, LO_WOUT = LO_WIN + SZ_WIN, LO_WGU2 = LO_WOUT + SZ_WOUT, LO_WD2 = LO_WGU2 + SZ_WGU, LO_SGUW = LO_WD2 + SZ_WD, L_STRIDE = LO_SGUW + SZ_SGUW;
constexpr size_t WS_W = 0, WS_X = WS_W + DEPTH * L_STRIDE, WS_XB = WS_X + (size_t)M * DM * 4, WS_RS = WS_XB + (size_t)M * DM * 2, WS_OV = WS_RS + (size_t)2 * M * 16 * 4;
constexpr size_t WS_ACT = WS_OV;
constexpr size_t WS_Z = WS_OV, WS_Q = WS_Z + (size_t)M * 1024 * 2, WS_K = WS_Q + (size_t)M * 512 * 2, WS_VT = WS_K + (size_t)M * 512 * 2, WS_Y = WS_VT + (size_t)M * 512 * 2;
constexpr size_t WS_CTL = WS_Y + (size_t)M * 1024 * 2, CTL_BYTES = 65536;
constexpr size_t WS_END = WS_CTL + CTL_BYTES;
static_assert(WS_ACT + (size_t)M * DFF * 2 <= WS_CTL, "overlay");
static_assert(L_STRIDE % 256 == 0 && WS_X % 256 == 0 && WS_OV % 256 == 0, "alignment");

__device__ __forceinline__ unsigned f2bf(float f) { unsigned u = __builtin_bit_cast(unsigned, f); return (u + 0x7fffu + ((u >> 16) & 1u)) >> 16; }
__device__ __forceinline__ unsigned pk2(float lo, float hi) { return f2bf(lo) | (f2bf(hi) << 16); }
typedef float f32x2_t __attribute__((ext_vector_type(2))); typedef __bf16 bf16x2_t __attribute__((ext_vector_type(2)));
__device__ __forceinline__ unsigned cvtpk(float lo, float hi) { f32x2_t v = {lo, hi}; bf16x2_t b = __builtin_convertvector(v, bf16x2_t); return __builtin_bit_cast(unsigned, b); }
__device__ __forceinline__ float bflo(unsigned w) { return __builtin_bit_cast(float, w << 16); }
__device__ __forceinline__ float bfhi(unsigned w) { return __builtin_bit_cast(float, w & 0xffff0000u); }
__device__ __forceinline__ float wave_sum(float v) {
#pragma unroll
    for (int o = 1; o < 64; o <<= 1) v += __shfl_xor(v, o);
    return v;
}
#define WG_BAR() do { asm volatile("s_waitcnt vmcnt(0) lgkmcnt(0)" ::: "memory"); __builtin_amdgcn_s_barrier(); asm volatile("" ::: "memory"); } while (0)

#define XB_TMO      128
#define XB_XCNT(j)  (256  + 64 * (j))
#define XB_XSUB(j)  (1280 + 64 * (j))
#define XB_XGEN(j)  (2304 + 64 * (j))
#define XB_TOP      3328
#define XB_TOPGEN   3392
#define XCD_BAR_WORDS 3456
#define XB_SPIN_CAP (1u << 22)

__device__ __forceinline__ unsigned xb_ld(unsigned* p)              { return __hip_atomic_load(p, __ATOMIC_RELAXED, __HIP_MEMORY_SCOPE_AGENT); }
__device__ __forceinline__ unsigned xb_add(unsigned* p, unsigned v) { return __hip_atomic_fetch_add(p, v, __ATOMIC_RELAXED, __HIP_MEMORY_SCOPE_AGENT); }
__device__ __forceinline__ unsigned xb_xcc_id() { return (unsigned)__builtin_amdgcn_s_getreg((3 << 11) | 20) & 0xFu; }
#define XB_SPIN(cond, bar) do { unsigned _sp = 0; while (cond) { __builtin_amdgcn_s_sleep(1); \
    if ((++_sp & 255u) == 0u) { if (xb_ld(&(bar)[XB_TMO])) break; if (_sp > XB_SPIN_CAP) { atomicAdd(&(bar)[XB_TMO], 1u); break; } } } } while (0)

struct XcdBarrier {
    unsigned* bar; unsigned x;
    volatile LAS unsigned* st;
};

__device__ __forceinline__ XcdBarrier xcd_barrier_post(unsigned* bar, volatile LAS unsigned* st) {
    XcdBarrier b; b.bar = bar; b.x = xb_xcc_id(); b.st = st;
    if (threadIdx.x == 0) (void)xb_add(&bar[XB_XCNT(b.x)], 1u);
    return b;
}
__device__ __forceinline__ void xcd_barrier_complete(unsigned* bar, unsigned x, unsigned& nloc, unsigned& nx) {
    const unsigned G = gridDim.x * gridDim.y * gridDim.z;
    unsigned sum, cnt, mine, sp = 0u;
    for (;;) {
        sum = 0u; cnt = 0u; mine = 0u;
#pragma unroll
        for (unsigned j = 0; j < 16; ++j) { const unsigned c = xb_ld(&bar[XB_XCNT(j)]); sum += c; cnt += (c > 0u) ? 1u : 0u; mine = (j == x) ? c : mine; }
        if (sum == G) break;
        __builtin_amdgcn_s_sleep(1);
        if ((++sp & 255u) == 0u) { if (xb_ld(&bar[XB_TMO])) break; if (sp > XB_SPIN_CAP) { atomicAdd(&bar[XB_TMO], 1u); break; } }
    }
    nloc = mine > 0u ? mine : 1u; nx = cnt > 0u ? cnt : 1u;
}

__device__ __forceinline__ void xcd_barrier(const XcdBarrier& b) {
    asm volatile("s_waitcnt vmcnt(0)" ::: "memory");
    __syncthreads();
    if (threadIdx.x == 0) {
        unsigned* bar = b.bar;
        __builtin_amdgcn_s_waitcnt(0);
        unsigned nloc = b.st[0], nx = b.st[1];
        if (nloc == 0u) { xcd_barrier_complete(bar, b.x, nloc, nx); b.st[0] = nloc; b.st[1] = nx; }
        const unsigned old = xb_add(&bar[XB_XSUB(b.x)], 1u);
        const unsigned gen = old / nloc;
        if (old + 1u == (gen + 1u) * nloc) {
            __builtin_amdgcn_fence(__ATOMIC_RELEASE, "agent");
            asm volatile("s_waitcnt vmcnt(0)" ::: "memory");
            const unsigned og = xb_add(&bar[XB_TOP], 1u);
            const unsigned tg = og / nx;
            if (og + 1u == (tg + 1u) * nx) xb_add(&bar[XB_TOPGEN], 1u);
            else XB_SPIN(xb_ld(&bar[XB_TOPGEN]) == tg, bar);
            __builtin_amdgcn_fence(__ATOMIC_ACQUIRE, "agent");
            xb_add(&bar[XB_XGEN(b.x)], 1u);
            asm volatile("s_waitcnt vmcnt(0)" ::: "memory");
        } else {
            XB_SPIN(xb_ld(&bar[XB_XGEN(b.x)]) == gen, bar);
            __builtin_amdgcn_fence(__ATOMIC_ACQUIRE, "agent");
            asm volatile("s_waitcnt vmcnt(0)" ::: "memory");
        }
    }
    __syncthreads();
}

constexpr int TR_SCR = 64 * 65 * 4;
__device__ __forceinline__ void tr_item(const float* W, int K, int N, const float* gain, bf16_t* WT, int mode, LAS float* scr, int item, int lane) {
    const int nblk = N / 64, kb = item / nblk, nb = item % nblk, k0 = 64 * kb, n0 = 64 * nb;
    const int lr = lane >> 4, n4 = 4 * (lane & 15);
    f32x4 v[16]; float gk[16];
    const float* src = W + (size_t)(k0 + lr) * N + n0 + n4;
    if (gain) {
#pragma unroll
        for (int i = 0; i < 16; ++i) gk[i] = gain[k0 + 4 * i + lr];
    } else {
#pragma unroll
        for (int i = 0; i < 16; ++i) gk[i] = 1.0f;
    }
#pragma unroll
    for (int i = 0; i < 16; ++i) v[i] = *(const f32x4*)(src + (size_t)(4 * i) * N);
#pragma unroll
    for (int i = 0; i < 16; ++i) v[i] = v[i] * gk[i];
#pragma unroll
    for (int i = 0; i < 16; ++i) { LAS float* d = scr + (4 * i + lr) * 65 + n4; d[0] = v[i][0]; d[1] = v[i][1]; d[2] = v[i][2]; d[3] = v[i][3]; }
    asm volatile("s_waitcnt lgkmcnt(0)" ::: "memory");
    const int c = lane & 7;
#pragma unroll
    for (int j = 0; j < 8; ++j) { const int n = (lane >> 3) + 8 * j; const LAS float* s = scr + (8 * c) * 65 + n;
        u32x4 o; o.x = pk2(s[0 * 65], s[1 * 65]); o.y = pk2(s[2 * 65], s[3 * 65]); o.z = pk2(s[4 * 65], s[5 * 65]); o.w = pk2(s[6 * 65], s[7 * 65]);
        const int nn = n0 + n; const int dr = (mode == 0) ? nn : (256 * (nn >> 7) + (nn & 127) + (mode == 2 ? 128 : 0));
        *(u32x4*)(WT + (size_t)dr * K + k0 + 8 * c) = o; }
    asm volatile("s_waitcnt lgkmcnt(0)" ::: "memory");
}

struct Args { const float* in[21]; float* out; unsigned char* ws; };
enum { I_X = 0, I_F1N, I_F1G, I_F1U, I_F1D, I_MIXN, I_WIN, I_SGUN, I_SGUW, I_SGUB, I_LQ1, I_LK1, I_LQ2, I_LK2, I_SUBLN, I_WOUT, I_F2N, I_F2G, I_F2U, I_F2D, I_FINN };

constexpr int IT_GU = (DM / 64) * (DFF / 64), IT_D = (DFF / 64) * (DM / 64), IT_IN = (DM / 64) * (NIN / 64), IT_OUT = (DM / 64) * (DM / 64);
constexpr int IT_FFN = 2 * IT_GU + IT_D, IT_LAYER = 2 * IT_FFN + IT_IN + IT_OUT;
__device__ __forceinline__ void convert_items(const Args& a, LAS unsigned char* lds, int l, int it0, int it1, int w, int nw, int wave, int lane) {
    LAS float* scr = (LAS float*)(lds + wave * TR_SCR);
    unsigned char* wl = a.ws + WS_W + (size_t)l * L_STRIDE;
    for (int it = it0 + w; it < it1; it += nw) {
        int r = it;
        if (r < 2 * IT_FFN) {
            const int f = r / IT_FFN; r -= f * IT_FFN;
            const float* gn = a.in[f ? I_F2N : I_F1N] + (size_t)l * DM;
            bf16_t* wgu = (bf16_t*)(wl + (f ? LO_WGU2 : LO_WGU1)); bf16_t* wd = (bf16_t*)(wl + (f ? LO_WD2 : LO_WD1));
            if (r < IT_GU) tr_item(a.in[f ? I_F2G : I_F1G] + (size_t)l * DM * DFF, DM, DFF, gn, wgu, 1, scr, r, lane);
            else if (r < 2 * IT_GU) tr_item(a.in[f ? I_F2U : I_F1U] + (size_t)l * DM * DFF, DM, DFF, gn, wgu, 2, scr, r - IT_GU, lane);
            else tr_item(a.in[f ? I_F2D : I_F1D] + (size_t)l * DFF * DM, DFF, DM, nullptr, wd, 0, scr, r - 2 * IT_GU, lane);
        } else {
            r -= 2 * IT_FFN;
            if (r < IT_IN) tr_item(a.in[I_WIN] + (size_t)l * DM * NIN, DM, NIN, a.in[I_MIXN] + (size_t)l * DM, (bf16_t*)(wl + LO_WIN), 0, scr, r, lane);
            else tr_item(a.in[I_WOUT] + (size_t)l * DM * DM, DM, DM, nullptr, (bf16_t*)(wl + LO_WOUT), 0, scr, r - IT_IN, lane);
        }
    }
}
__device__ __forceinline__ bool slot_range(int l, int slot, int& layer, int& s0, int& s1) {
    if (l == 0) { if (slot == 0) { layer = 0; s0 = 2 * IT_GU; s1 = IT_LAYER; } else { layer = 1; s0 = (slot - 1) * (IT_LAYER / 2); s1 = slot * (IT_LAYER / 2); } return true; }
    if (l + 1 >= DEPTH) return false;
    layer = l + 1; s0 = (IT_LAYER * slot) / 3; s1 = (IT_LAYER * (slot + 1)) / 3; return true;
}
__device__ __forceinline__ void prologue(const Args& a, LAS unsigned char* lds, int vcu, int G, int wave, int lane) {
    const int gw = vcu * NWAVES + wave, NGW = G * NWAVES;
    if (G == 256) convert_items(a, lds, 0, 0, 2 * IT_GU, gw, NGW, wave, lane);
    else for (int l = 0; l < DEPTH; ++l) convert_items(a, lds, l, 0, IT_LAYER, gw, NGW, wave, lane);
    {
        const int gt = vcu * NTHREADS + wave * 64 + lane, NT = G * NTHREADS;
        for (int i = gt; i < DEPTH * 8 * 128 * 128 / 4; i += NT) {
            const int e0 = i * 4, l = e0 >> 17, rem = e0 & 131071, t = (rem >> 7) & 127, s0 = rem & 127;
            const f32x4 w = *(const f32x4*)(a.in[I_SGUW] + e0);
            u32x2 o; o.x = pk2(s0 + 0 <= t ? w[0] : 0.f, s0 + 1 <= t ? w[1] : 0.f); o.y = pk2(s0 + 2 <= t ? w[2] : 0.f, s0 + 3 <= t ? w[3] : 0.f);
            *(u32x2*)((bf16_t*)(a.ws + WS_W + (size_t)l * L_STRIDE + LO_SGUW) + rem) = o;
        }
    }
    {
        const float* x = a.in[I_X]; bf16_t* XB = (bf16_t*)(a.ws + WS_XB); float* rs = (float*)(a.ws + WS_RS);
        for (int m0 = 2 * gw; m0 < M; m0 += 2 * NGW) {
            f32x4 v[2][4];
#pragma unroll
            for (int q = 0; q < 2; ++q)
#pragma unroll
                for (int j = 0; j < 4; ++j) v[q][j] = ((const f32x4*)(x + (size_t)(m0 + q) * DM) + lane)[64 * j];
#pragma unroll
            for (int q = 0; q < 2; ++q) {
                const int m = m0 + q; float s = 0.f;
#pragma unroll
                for (int j = 0; j < 4; ++j) s += (v[q][j][0] * v[q][j][0] + v[q][j][1] * v[q][j][1]) + (v[q][j][2] * v[q][j][2] + v[q][j][3] * v[q][j][3]);
                s = wave_sum(s);
                u32x2* bo = (u32x2*)(XB + (size_t)m * DM) + lane;
#pragma unroll
                for (int j = 0; j < 4; ++j) { u32x2 o; o.x = pk2(v[q][j][0], v[q][j][1]); o.y = pk2(v[q][j][2], v[q][j][3]); bo[64 * j] = o; }
                if (lane < 16) rs[(size_t)m * 16 + lane] = (lane == 0) ? s : 0.f;
            }
        }
    }
}

__device__ __forceinline__ void sgu_unit(LAS unsigned char* lds, const bf16_t* Z, const bf16_t* Wb, const float* ngain, const float* bias, bf16_t* Y, int b, int c, int g) {
    int tid_ = threadIdx.x; asm volatile("" : "+v"(tid_));
    const int tid = tid_, lane = tid & 63, wid = __builtin_amdgcn_readfirstlane(tid >> 6), r32 = lane & 31, hi = lane >> 5;
    const size_t rowbase = (size_t)b * SEQ + (size_t)c * 128;
    bf16x8 wf[8]; u32x2 uu[4]; float bs;
    {
        const int dc_ = wid & 1, tc_ = wid >> 1, t_ = 32 * tc_ + r32;
        const bf16_t* bp_ = Wb + (size_t)t_ * 128 + 8 * hi;
#pragma unroll
        for (int kk = 0; kk < 8; ++kk) wf[kk] = *(const bf16x8*)(bp_ + 16 * kk);
        const bf16_t* up_ = Z + (rowbase + t_) * 1024 + g * 64 + 32 * dc_ + 4 * hi;
#pragma unroll
        for (int j = 0; j < 4; ++j) uu[j] = *(const u32x2*)(up_ + 8 * j);
        bs = bias[t_];
    }
    const f32x4 ng0 = *(const f32x4*)(ngain + (tid & 7) * 8), ng1 = *(const f32x4*)(ngain + (tid & 7) * 8 + 4);
#pragma unroll
    for (int i = 0; i < 2; ++i) {
        const int cid = tid + 512 * i, s = cid >> 3, ch = cid & 7;
        const u32x4 raw = *(const u32x4*)(Z + (rowbase + s) * 1024 + 512 + g * 64 + ch * 8);
        float v[8]; v[0] = bflo(raw.x); v[1] = bfhi(raw.x); v[2] = bflo(raw.y); v[3] = bfhi(raw.y); v[4] = bflo(raw.z); v[5] = bfhi(raw.z); v[6] = bflo(raw.w); v[7] = bfhi(raw.w);
        float ss = 0.f;
#pragma unroll
        for (int e = 0; e < 8; ++e) ss += v[e] * v[e];
        ss += __builtin_bit_cast(float, __builtin_amdgcn_update_dpp(0, __builtin_bit_cast(int, ss), 0xB1, 0xF, 0xF, false));
        ss += __builtin_bit_cast(float, __builtin_amdgcn_update_dpp(0, __builtin_bit_cast(int, ss), 0x4E, 0xF, 0xF, false));
        ss += __builtin_bit_cast(float, __builtin_amdgcn_update_dpp(0, __builtin_bit_cast(int, ss), 0x141, 0xF, 0xF, false));
        const float rstd = __builtin_amdgcn_rsqf(ss * (1.0f / 64.0f) + 1e-6f);
        const float gg[8] = {ng0[0], ng0[1], ng0[2], ng0[3], ng1[0], ng1[1], ng1[2], ng1[3]};
        const int pc = ((s >> 3) ^ ch) * 16 + (s & 7) * 2;
#pragma unroll
        for (int e = 0; e < 8; ++e) *(LAS unsigned short*)(lds + (ch * 8 + e) * 272 + pc) = (unsigned short)f2bf(v[e] * rstd * gg[e]);
    }
    WG_BAR();
    const int dc = wid & 1, tc = wid >> 1;
    f32x16 acc;
#pragma unroll
    for (int r = 0; r < 16; ++r) acc[r] = 0.f;
    const int d = 32 * dc + r32, t = 32 * tc + r32;
    const LAS unsigned char* ap = lds + d * 272; const int dsw = (d >> 3) & 7;
    const bf16_t* bp = Wb + (size_t)t * 128 + 8 * hi;
    bf16x8 af[8];
#pragma unroll
    for (int kk = 0; kk < 8; ++kk) af[kk] = *(const LAS bf16x8*)(ap + (((2 * kk + hi) ^ dsw) * 16));
#pragma unroll
    for (int kk = 0; kk < 8; ++kk) {
        if (kk < 2 * tc + 2) acc = __builtin_amdgcn_mfma_f32_32x32x16_bf16(af[kk], wf[kk], acc, 0, 0, 0);
    }
    bf16_t* yp = Y + (rowbase + t) * 1024 + g * 64 + 32 * dc + 4 * hi;
#pragma unroll
    for (int j = 0; j < 4; ++j) {
        u32x2 o; o.x = cvtpk(bflo(uu[j].x) * (acc[4 * j + 0] + bs), bfhi(uu[j].x) * (acc[4 * j + 1] + bs)); o.y = cvtpk(bflo(uu[j].y) * (acc[4 * j + 2] + bs), bfhi(uu[j].y) * (acc[4 * j + 3] + bs));
        *(u32x2*)(yp + 8 * j) = o;
    }
    WG_BAR();
}

namespace att {
constexpr float ATT_THR = 8.0f;
constexpr int KSTR = 144, K_BYTES = 64 * KSTR, V_BYTES = 128 * KSTR, STAGE = 2 * K_BYTES + V_BYTES, NSTG = 3, COMB_OFF = 0;
static_assert(NSTG * STAGE <= LDS_BYTES - 64 && COMB_OFF + 65536 <= NSTG * STAGE, "attention LDS");
}
__device__ __forceinline__ void attn_scores(const LAS unsigned char* sb, int kt, int qabs, int map, int pir, int hi, float cb, float mref, const bf16x8 (&qf)[4], f32x16& p0, f32x16& p1) {
    using namespace att;
    const LAS unsigned char* kp = sb + map * K_BYTES + pir * KSTR + hi * 16;
    const float lb0 = cb * (float)(64 * kt + 8 * hi - qabs) - mref, lb1 = lb0 + cb * 32.0f;
#pragma unroll
    for (int r = 0; r < 16; ++r) { const float kc = (float)(16 * (r >> 3) + (r & 7)); p0[r] = __builtin_fmaf(cb, kc, lb0); p1[r] = __builtin_fmaf(cb, kc, lb1); }
#pragma unroll
    for (int hb = 0; hb < 2; ++hb) {
        bf16x8 kf[4];
#pragma unroll
        for (int d = 0; d < 2; ++d) { kf[2 * d] = *(const LAS bf16x8*)(kp + (2 * hb + d) * 32); kf[2 * d + 1] = *(const LAS bf16x8*)(kp + 32 * KSTR + (2 * hb + d) * 32); }
        __builtin_amdgcn_sched_barrier(0);
        __builtin_amdgcn_s_setprio(1);
#pragma unroll
        for (int d = 0; d < 2; ++d) {
            p0 = __builtin_amdgcn_mfma_f32_32x32x16_bf16(kf[2 * d], qf[2 * hb + d], p0, 0, 0, 0);
            p1 = __builtin_amdgcn_mfma_f32_32x32x16_bf16(kf[2 * d + 1], qf[2 * hb + d], p1, 0, 0, 0);
        }
        __builtin_amdgcn_s_setprio(0);
        __builtin_amdgcn_sched_barrier(0);
    }
}
__device__ __forceinline__ void attn_softmax(int kt, int qb, int qabs, int hi, f32x16& p0, f32x16& p1, f32x16 (&o)[4], float& mref, float& lrun, bool& mset, bf16x8 (&pf)[4]) {
    using namespace att;
    if (kt >= 2 * qb) {
        const int kbase = 64 * kt + 8 * hi;
#pragma unroll
        for (int r = 0; r < 16; ++r) { const int key = kbase + 16 * (r >> 3) + (r & 7); if (key > qabs) p0[r] = -1e30f; if (key + 32 > qabs) p1[r] = -1e30f; }
    }
    asm volatile("s_nop 15\n\ts_nop 7" : "+v"(p0), "+v"(p1));
    float mx, mx2;
    asm("v_max3_f32 %0, %1, %2, %3" : "=v"(mx) : "v"(p0[0]), "v"(p1[0]), "v"(p0[1]));
    asm("v_max3_f32 %0, %1, %2, %3" : "=v"(mx2) : "v"(p1[1]), "v"(p0[2]), "v"(p1[2]));
#pragma unroll
    for (int r = 3; r < 15; r += 2) {
        asm("v_max3_f32 %0, %1, %2, %3" : "=v"(mx) : "v"(mx), "v"(p0[r]), "v"(p1[r]));
        asm("v_max3_f32 %0, %1, %2, %3" : "=v"(mx2) : "v"(mx2), "v"(p0[r + 1]), "v"(p1[r + 1]));
    }
    asm("v_max3_f32 %0, %1, %2, %3" : "=v"(mx) : "v"(mx), "v"(p0[15]), "v"(p1[15]));
    asm("v_max3_f32 %0, %1, %2, %3" : "=v"(mx) : "v"(mx), "v"(mx2), "v"(mx2));
    { const auto rr = __builtin_amdgcn_permlane32_swap(__builtin_bit_cast(unsigned, mx), __builtin_bit_cast(unsigned, mx), false, false);
      const float ma = __builtin_bit_cast(float, (unsigned)rr[0]), mb = __builtin_bit_cast(float, (unsigned)rr[1]); asm("v_max3_f32 %0, %1, %2, %3" : "=v"(mx) : "v"(ma), "v"(mb), "v"(mb)); }
    const bool need = mset ? (mx > ATT_THR) : (mx > -1e29f);
    if (__any(need)) {
        const float delta = need ? mx : 0.f, f = (need && mset) ? __builtin_amdgcn_exp2f(-delta) : 1.0f;
        mref += delta; mset = mset || need; lrun *= f;
#pragma unroll
        for (int r = 0; r < 16; ++r) { p0[r] -= delta; p1[r] -= delta; }
#pragma unroll
        for (int c = 0; c < 4; ++c)
#pragma unroll
            for (int r = 0; r < 16; ++r) o[c][r] *= f;
    }
    float ps = 0.f;
#pragma unroll
    for (int r = 0; r < 16; ++r) { p0[r] = __builtin_amdgcn_exp2f(p0[r]); p1[r] = __builtin_amdgcn_exp2f(p1[r]); ps += p0[r] + p1[r]; }
    lrun += ps;
    u32x4 w;
    w.x = cvtpk(p0[0], p0[1]); w.y = cvtpk(p0[2], p0[3]); w.z = cvtpk(p0[4], p0[5]); w.w = cvtpk(p0[6], p0[7]); pf[0] = __builtin_bit_cast(bf16x8, w);
    w.x = cvtpk(p0[8], p0[9]); w.y = cvtpk(p0[10], p0[11]); w.z = cvtpk(p0[12], p0[13]); w.w = cvtpk(p0[14], p0[15]); pf[1] = __builtin_bit_cast(bf16x8, w);
    w.x = cvtpk(p1[0], p1[1]); w.y = cvtpk(p1[2], p1[3]); w.z = cvtpk(p1[4], p1[5]); w.w = cvtpk(p1[6], p1[7]); pf[2] = __builtin_bit_cast(bf16x8, w);
    w.x = cvtpk(p1[8], p1[9]); w.y = cvtpk(p1[10], p1[11]); w.z = cvtpk(p1[12], p1[13]); w.w = cvtpk(p1[14], p1[15]); pf[3] = __builtin_bit_cast(bf16x8, w);
}
__device__ __forceinline__ void attn_pv(const LAS unsigned char* sb, int r32, int hi, const bf16x8 (&pf)[4], f32x16 (&o)[4]) {
    using namespace att;
    const LAS unsigned char* vp = sb + 2 * K_BYTES + r32 * KSTR + hi * 16;
    bf16x8 va[4], vb[4];
#pragma unroll
    for (int c = 0; c < 4; ++c) va[c] = *(const LAS bf16x8*)(vp + c * 32 * KSTR);
    __builtin_amdgcn_sched_barrier(0);
#pragma unroll
    for (int c = 0; c < 4; ++c) vb[c] = *(const LAS bf16x8*)(vp + c * 32 * KSTR + 32);
    __builtin_amdgcn_s_setprio(1);
#pragma unroll
    for (int c = 0; c < 4; ++c) o[c] = __builtin_amdgcn_mfma_f32_32x32x16_bf16(va[c], pf[0], o[c], 0, 0, 0);
    __builtin_amdgcn_s_setprio(0);
    __builtin_amdgcn_sched_barrier(0);
#pragma unroll
    for (int c = 0; c < 4; ++c) va[c] = *(const LAS bf16x8*)(vp + c * 32 * KSTR + 64);
    __builtin_amdgcn_s_setprio(1);
#pragma unroll
    for (int c = 0; c < 4; ++c) o[c] = __builtin_amdgcn_mfma_f32_32x32x16_bf16(vb[c], pf[1], o[c], 0, 0, 0);
    __builtin_amdgcn_s_setprio(0);
    __builtin_amdgcn_sched_barrier(0);
#pragma unroll
    for (int c = 0; c < 4; ++c) vb[c] = *(const LAS bf16x8*)(vp + c * 32 * KSTR + 96);
    __builtin_amdgcn_s_setprio(1);
#pragma unroll
    for (int c = 0; c < 4; ++c) o[c] = __builtin_amdgcn_mfma_f32_32x32x16_bf16(va[c], pf[2], o[c], 0, 0, 0);
    __builtin_amdgcn_s_setprio(0);
    __builtin_amdgcn_sched_barrier(0);
    __builtin_amdgcn_s_setprio(1);
#pragma unroll
    for (int c = 0; c < 4; ++c) o[c] = __builtin_amdgcn_mfma_f32_32x32x16_bf16(vb[c], pf[3], o[c], 0, 0, 0);
    __builtin_amdgcn_s_setprio(0);
    __builtin_amdgcn_sched_barrier(0);
}
__device__ __forceinline__ void attn_step(const LAS unsigned char* sb, const LAS unsigned char* sb_prev, int kt, int qb, int qabs, int qmax_w, int map, int pir, int r32, int hi, float cb, const bf16x8 (&qf)[4],
                                          f32x16 (&o)[4], float& mref, float& lrun, bool& mset, bf16x8 (&pf)[4], bool& pend) {
    const bool have = 64 * kt <= qmax_w;
    f32x16 p0, p1;
    if (pend) attn_pv(sb_prev, r32, hi, pf, o);
    pend = false;
    if (have) {
        attn_scores(sb, kt, qabs, map, pir, hi, cb, mref, qf, p0, p1);
        attn_softmax(kt, qb, qabs, hi, p0, p1, o, mref, lrun, mset, pf);
        if (map == 0) attn_pv(sb, r32, hi, pf, o); else pend = true;
    }
}
#define LBAR() do { asm volatile("s_waitcnt lgkmcnt(0)" ::: "memory"); __builtin_amdgcn_s_barrier(); asm volatile("" ::: "memory"); } while (0)
__device__ __forceinline__ void attn_unit(LAS unsigned char* lds, const bf16_t* Q, const bf16_t* Kg, const bf16_t* Vt, bf16_t* Y, int b, int h, int qb, float cb, float lam, const float* subgain, float outscale) {
    using namespace att;
    int tid_ = threadIdx.x; asm volatile("" : "+v"(tid_));
    const int tid = tid_, lane = tid & 63, wid = __builtin_amdgcn_readfirstlane(tid >> 6), map = wid >> 2, g = wid & 3, r32 = lane & 31, hi = lane >> 5;
    const size_t rowbase = (size_t)b * SEQ; const int q0 = qb * 128, qabs = q0 + 32 * g + r32;
    const int nt = 2 * qb + 2;
    const int krow = tid >> 4, kch = tid & 15, vrow = tid >> 3, vch = tid & 7;
    const bf16_t* kg = Kg + (rowbase + krow) * 512 + h * 128 + kch * 8;
    const bf16_t* vg = Vt + ((size_t)(b * 4 + h) * 128 + vrow) * 2048 + vch * 8;
    const int klds = (kch >> 3) * K_BYTES + krow * KSTR + (kch & 7) * 16, vlds = 2 * K_BYTES + vrow * KSTR + vch * 16;
    u32x4 Ak0, Ak1, Av0, Av1, Bk0, Bk1, Bv0, Bv1;
#define ATT_GLOAD(S, j) do { const int kt_ = (nt - 1 - (j)) > 0 ? (nt - 1 - (j)) : 0; \
                              S##k0 = *(const u32x4*)(kg + (size_t)kt_ * 64 * 512); S##k1 = *(const u32x4*)(kg + (size_t)kt_ * 64 * 512 + 32 * 512); \
                              S##v0 = *(const u32x4*)(vg + kt_ * 64); S##v1 = *(const u32x4*)(vg + kt_ * 64 + (size_t)64 * 2048); } while (0)
#define ATT_LSTORE(S, sb_) do { *(LAS u32x4*)((sb_) + klds) = S##k0; *(LAS u32x4*)((sb_) + klds + 32 * KSTR) = S##k1; \
                                *(LAS u32x4*)((sb_) + vlds) = S##v0; *(LAS u32x4*)((sb_) + vlds + 64 * KSTR) = S##v1; } while (0)
    bf16x8 qf[4];
    { const bf16_t* qp = Q + (rowbase + qabs) * 512 + h * 128 + map * 64 + hi * 8;
#pragma unroll
      for (int d0 = 0; d0 < 4; ++d0) qf[d0] = *(const bf16x8*)(qp + d0 * 16); }
    ATT_GLOAD(A, 0); ATT_GLOAD(B, 1);
    __builtin_amdgcn_s_waitcnt(0x0F74);
    f32x16 o[4];
#pragma unroll
    for (int c = 0; c < 4; ++c)
#pragma unroll
        for (int r = 0; r < 16; ++r) o[c][r] = 0.f;
    float mref = 0.f, lrun = 0.f; bool mset = false, pend = false;
    bf16x8 pf[4];
#pragma unroll
    for (int i = 0; i < 4; ++i) pf[i] = (bf16x8){0, 0, 0, 0, 0, 0, 0, 0};
    const int pir = (r32 & 19) | ((r32 & 4) << 1) | ((r32 & 8) >> 1);
    const int qmax_w = q0 + 32 * g + 31;
    LAS unsigned char* s_prev = lds + 2 * STAGE; LAS unsigned char* s_cur = lds; LAS unsigned char* s_next = lds + STAGE;
#define ATT_ROT() do { LAS unsigned char* t_ = s_prev; s_prev = s_cur; s_cur = s_next; s_next = t_; } while (0)
    ATT_LSTORE(A, s_cur); LBAR();
    for (int j = 0; j < nt; j += 2) {
        ATT_GLOAD(A, j + 2);
        attn_step(s_cur, s_prev, nt - 1 - j, qb, qabs, qmax_w, map, pir, r32, hi, cb, qf, o, mref, lrun, mset, pf, pend);
        ATT_LSTORE(B, s_next); LBAR(); ATT_ROT();
        ATT_GLOAD(B, j + 3);
        attn_step(s_cur, s_prev, nt - 2 - j, qb, qabs, qmax_w, map, pir, r32, hi, cb, qf, o, mref, lrun, mset, pf, pend);
        ATT_LSTORE(A, s_next); LBAR(); ATT_ROT();
    }
    if (map == 1 && pend) attn_pv(s_prev, r32, hi, pf, o);
    LBAR();
#undef ATT_ROT
#undef ATT_GLOAD
#undef ATT_LSTORE
    const float ltot = lrun + __shfl_xor(lrun, 32), inv = 1.0f / ltot;
    LAS float* comb = (LAS float*)(lds + COMB_OFF) + g * 4096 + r32;
    if (map == 1) {
        const float f = lam * inv;
#pragma unroll
        for (int c = 0; c < 4; ++c)
#pragma unroll
            for (int r = 0; r < 16; ++r) comb[(32 * c + (r & 3) + 8 * (r >> 2) + 4 * hi) * 32] = o[c][r] * f;
    }
    f32x4 gn[16];
#pragma unroll
    for (int c = 0; c < 4; ++c)
#pragma unroll
        for (int j = 0; j < 4; ++j) gn[c * 4 + j] = *(const f32x4*)(subgain + 32 * c + 8 * j + 4 * hi);
    LBAR();
    if (map == 0) {
        float ss = 0.f;
#pragma unroll
        for (int c = 0; c < 4; ++c)
#pragma unroll
            for (int r = 0; r < 16; ++r) { const float v = o[c][r] * inv - comb[(32 * c + (r & 3) + 8 * (r >> 2) + 4 * hi) * 32]; o[c][r] = v; ss += v * v; }
        ss += __shfl_xor(ss, 32);
        const float rstd = __builtin_amdgcn_rsqf(ss * (1.0f / 128.0f) + 1e-6f) * outscale;
        bf16_t* yp = Y + (rowbase + qabs) * 1024 + 512 + h * 128 + 4 * hi;
#pragma unroll
        for (int c = 0; c < 4; ++c)
#pragma unroll
            for (int j = 0; j < 4; ++j) {
                const f32x4 gq = gn[c * 4 + j];
                u32x2 w; w.x = cvtpk(o[c][4 * j + 0] * rstd * gq[0], o[c][4 * j + 1] * rstd * gq[1]); w.y = cvtpk(o[c][4 * j + 2] * rstd * gq[2], o[c][4 * j + 3] * rstd * gq[3]);
                *(u32x2*)(yp + 32 * c + 8 * j) = w;
            }
    }
    LBAR();
}

__global__ void __launch_bounds__(NTHREADS, 2) hybrid_fwd(Args a) {
    extern __shared__ __attribute__((aligned(16))) unsigned char lds_raw[];
    LAS unsigned char* lds = (LAS unsigned char*)lds_raw;
    cg::grid_group grid = cg::this_grid();
    const int G = gridDim.x, bx = blockIdx.x, vcu = (G % 8 == 0) ? (bx % 8) * (G / 8) + bx / 8 : bx;
    unsigned char* ws = a.ws;
    if (threadIdx.x < 16) ((LAS unsigned*)(lds + LDS_BYTES - 64))[threadIdx.x] = 0u;
    __syncthreads();
    const XcdBarrier bar = xcd_barrier_post((unsigned*)(ws + WS_CTL), (volatile LAS unsigned*)(lds + LDS_BYTES - 64));
    float* X = (float*)(ws + WS_X); bf16_t* XB = (bf16_t*)(ws + WS_XB); float* RS = (float*)(ws + WS_RS);
    bf16_t* ACT = (bf16_t*)(ws + WS_ACT); bf16_t* Zb = (bf16_t*)(ws + WS_Z); bf16_t* Qb = (bf16_t*)(ws + WS_Q); bf16_t* Kb = (bf16_t*)(ws + WS_K); bf16_t* Vtb = (bf16_t*)(ws + WS_VT); bf16_t* Yb = (bf16_t*)(ws + WS_Y);

#ifndef NO_PRO
    for (int rep_ = 0; rep_ < PROBE_PRO_REPS; ++rep_) { int t_ = threadIdx.x; asm volatile("" : "+v"(t_)); prologue(a, lds, vcu, G, __builtin_amdgcn_readfirstlane(t_ >> 6), t_ & 63); }
#endif
    grid.sync();
    xcd_barrier(bar);

#pragma unroll 1
    for (int st = 0; st < 3 * DEPTH; ++st) {
        const int l = st / 3, sub = st - 3 * l;
        unsigned char* wl = ws + WS_W + (size_t)l * L_STRIDE;
        const float* rs_in = RS + (size_t)(st & 1) * M * 16; float* rs_out = RS + (size_t)((st + 1) & 1) * M * 16;
        if (sub != 1) {
            for (int rep_ = 0; rep_ < PROBE_G1_REPS; ++rep_) {
                pg8::Gemm gm{XB, (const bf16_t*)(wl + (sub ? LO_WGU2 : LO_WGU1)), M, 2 * DFF, DM}; pg8::StaticOrder S; S.init(M, 2 * DFF, G, bx);
                pg8::EpiSwiglu E{ACT, DFF, rs_in};
#ifndef NO_G1
                pg8::gemm_phase<pg8::EpiSwiglu, pg8::StaticOrder, true, true>(lds, gm, S, E);
#endif
                int cl_ = 0, s0_ = 0, s1_ = 0;
                if (G == 256 && bx >= 128 && slot_range(l, sub ? 2 : 0, cl_, s0_, s1_)) {
                    int t_ = threadIdx.x; asm volatile("" : "+v"(t_));
                    convert_items(a, lds, cl_, s0_, s1_, (bx - 128) * NWAVES + __builtin_amdgcn_readfirstlane(t_ >> 6), 128 * NWAVES, __builtin_amdgcn_readfirstlane(t_ >> 6), t_ & 63);
                }
            }
            for (int rb_ = 0; rb_ < PROBE_BAR_REPS; ++rb_) xcd_barrier(bar);
            {
                pg8::Gemm gm{ACT, (const bf16_t*)(wl + (sub ? LO_WD2 : LO_WD1)), M, DM, DFF}; pg8::StaticOrder S; S.init(M, DM, G, bx);
                pg8::EpiResid E{st == 0 ? a.in[I_X] : (const float*)X, X, XB, rs_out, 0.5f};
#ifndef NO_G2
                pg8::gemm_phase<pg8::EpiResid, pg8::StaticOrder, true, true>(lds, gm, S, E);
#endif
            }
            for (int rb_ = 0; rb_ < PROBE_BAR_REPS; ++rb_) xcd_barrier(bar);
        } else {
            for (int rep_ = 0; rep_ < PROBE_G3_REPS; ++rep_) {
                pg8::Gemm gm{XB, (const bf16_t*)(wl + LO_WIN), M, NIN, DM}; pg8::StaticOrder S; S.init(M, NIN, G, bx);
                pg8::EpiWin E{Zb, Qb, Kb, Vtb, rs_in, 0.125f * 1.4426950408889634f};
#ifndef NO_G3
                pg8::gemm_phase<pg8::EpiWin, pg8::StaticOrder, true, true>(lds, gm, S, E);
#endif
                int cl_ = 0, s0_ = 0, s1_ = 0;
                if (G == 256 && bx >= 128 && slot_range(l, 1, cl_, s0_, s1_)) {
                    int t_ = threadIdx.x; asm volatile("" : "+v"(t_));
                    convert_items(a, lds, cl_, s0_, s1_, (bx - 128) * NWAVES + __builtin_amdgcn_readfirstlane(t_ >> 6), 128 * NWAVES, __builtin_amdgcn_readfirstlane(t_ >> 6), t_ & 63);
                }
            }
            for (int rb_ = 0; rb_ < PROBE_BAR_REPS; ++rb_) xcd_barrier(bar);
            for (int rep_ = 0; rep_ < PROBE_MIX_REPS; ++rep_) {
                const bf16_t* sw = (const bf16_t*)(wl + LO_SGUW);
                for (int rs_ = 0; rs_ < PROBE_SGU_REPS; ++rs_)
                for (int ui = vcu; ui < NB * 16 * 8; ui += G) {
                    const int g = ui & 7, c = (ui >> 3) & 15, b = ui >> 7;
#ifndef NO_SGU
                    sgu_unit(lds, Zb, sw + (size_t)g * 128 * 128, a.in[I_SGUN] + (size_t)l * 512 + g * 64, a.in[I_SGUB] + (size_t)l * 1024 + g * 128, Yb, b, c, g);
#endif
                }
                int t_ = threadIdx.x; asm volatile("" : "+v"(t_)); const int lane = t_ & 63;
                float lam_init = 0.8f - 0.6f * expf(-0.3f * (float)l);
                const float d1 = wave_sum(a.in[I_LQ1][l * 64 + lane] * a.in[I_LK1][l * 64 + lane]), d2 = wave_sum(a.in[I_LQ2][l * 64 + lane] * a.in[I_LK2][l * 64 + lane]);
                const float lam = expf(d1) - expf(d2) + lam_init;
                for (int ra_ = 0; ra_ < PROBE_ATT_REPS; ++ra_)
                for (int pi = vcu; pi < NB * 4 * 8; pi += G) {
                    const int bh = pi >> 3, s = pi & 7, b = bh >> 2, h = bh & 3;
                    const float cb = exp2f(-2.0f * (float)(h + 1)) * 1.4426950408889634f;
#pragma unroll 1
                    for (int i = 0; i < 2; ++i)
                    {
#ifndef NO_ATT
                        attn_unit(lds, Qb, Kb, Vtb, Yb, b, h, i ? 15 - s : s, cb, lam, a.in[I_SUBLN] + (size_t)l * 128, 1.0f - lam_init);
#endif
                    }
                }
            }
            for (int rb_ = 0; rb_ < PROBE_BAR_REPS; ++rb_) xcd_barrier(bar);
            {
                pg8::Gemm gm{Yb, (const bf16_t*)(wl + LO_WOUT), M, DM, DM}; pg8::StaticOrder S; S.init(M, DM, G, bx);
                pg8::EpiResid E{X, X, XB, rs_out, 1.0f};
#ifndef NO_G4
                pg8::gemm_phase<pg8::EpiResid, pg8::StaticOrder, true, true>(lds, gm, S, E);
#endif
            }
            for (int rb_ = 0; rb_ < PROBE_BAR_REPS; ++rb_) xcd_barrier(bar);
        }
    }
    {
        int t_ = threadIdx.x; asm volatile("" : "+v"(t_)); const int lane = t_ & 63, wave = __builtin_amdgcn_readfirstlane(t_ >> 6);
        const float* rs = RS; const float* fg = a.in[I_FINN];
        const int gw = vcu * NWAVES + wave, NGW = G * NWAVES;
        f32x4 gn[4];
#pragma unroll
        for (int j = 0; j < 4; ++j) gn[j] = *((const f32x4*)fg + lane + 64 * j);
        for (int m = gw; m < M; m += NGW) {
            float sq = 0.f;
#pragma unroll
            for (int q4 = 0; q4 < 4; ++q4) { const f32x4 pv = *(const f32x4*)(rs + (size_t)m * 16 + 4 * q4); sq += (pv[0] + pv[1]) + (pv[2] + pv[3]); }
            const float r = __builtin_amdgcn_rsqf(sq * (1.0f / 1024.0f) + 1e-6f);
            const f32x4* xr = (const f32x4*)(X + (size_t)m * DM) + lane; f32x4* orow = (f32x4*)(a.out + (size_t)m * DM) + lane;
#pragma unroll
            for (int j = 0; j < 4; ++j) orow[64 * j] = xr[64 * j] * r * gn[j];
        }
    }
}

extern "C" void kernel_launch(void* const* d_in, const int* in_sizes, int n_in, void* d_out, int out_size, void* d_ws, size_t ws_size, hipStream_t stream) {
    static int grid = 0;
    if (grid == 0) {
        if (n_in != 21 || out_size != M * DM || ws_size < WS_END) { fprintf(stderr, "kernel_launch: unexpected problem (n_in %d, out %d, ws %zu, need %zu)\n", n_in, out_size, ws_size, (size_t)WS_END); grid = -1; return; }
        int dev = 0, cus = 0, per_cu = 0;
        hipGetDevice(&dev); hipDeviceGetAttribute(&cus, hipDeviceAttributeMultiprocessorCount, dev);
        if (hipFuncSetAttribute((const void*)hybrid_fwd, hipFuncAttributeMaxDynamicSharedMemorySize, LDS_BYTES) != hipSuccess) { fprintf(stderr, "kernel_launch: hipFuncSetAttribute failed\n"); grid = -1; return; }
        if (hipOccupancyMaxActiveBlocksPerMultiprocessor(&per_cu, (const void*)hybrid_fwd, NTHREADS, LDS_BYTES) != hipSuccess || per_cu < 1) { fprintf(stderr, "kernel_launch: occupancy query says %d\n", per_cu); per_cu = 1; }
        (void)hipGetLastError();
        grid = cus * per_cu;
    }
    if (grid < 0) return;
    if (hipMemsetAsync((unsigned char*)d_ws + WS_CTL, 0, CTL_BYTES, stream) != hipSuccess) { fprintf(stderr, "kernel_launch: memset failed\n"); return; }
    Args a{};
    for (int i = 0; i < 21; ++i) a.in[i] = (const float*)d_in[i];
    a.out = (float*)d_out; a.ws = (unsigned char*)d_ws;
    void* args[] = {&a};
    hipError_t e = hipLaunchCooperativeKernel((const void*)hybrid_fwd, dim3(grid), dim3(NTHREADS), args, LDS_BYTES, stream);
    if (e != hipSuccess) fprintf(stderr, "cooperative launch failed: %s (grid %d)\n", hipGetErrorString(e), grid);
}
```
